# Optimizing an MI355X kernel written in HIP

```python
import math
import jax, jax.numpy as jnp
from jax import lax
import numpy as np

D_MODEL = 2048
BATCH = 16
SEQ = 2048
DEPTH = 1

HEAD_DIM = 128
MIX_WIDTH = D_MODEL
N_HEADS_DIFF = MIX_WIDTH // (2 * HEAD_DIM)
N_HEADS_DIL = MIX_WIDTH // (2 * HEAD_DIM)
DIFF_QK_DIM = HEAD_DIM // 2
DIFF_WIDTH = N_HEADS_DIFF * HEAD_DIM
DIL_WIDTH = N_HEADS_DIL * HEAD_DIM
IN_COLS = 3 * DIFF_WIDTH + 3 * DIL_WIDTH
D_FF = 4 * D_MODEL
DILATION_CONFIGS = ((128, 1), (512, 4), (2048, 16))
BLOCK = 128
ROPE_THETA = 10000.0
LN_EPS = 1e-5
SUBLN_EPS = 1e-5
NEG = -1e30
DEEPNORM_ALPHA = (2.0 * DEPTH) ** 0.25
DEEPNORM_BETA = (8.0 * DEPTH) ** -0.25

kernel_name = "hymba_diffattn_dilated_sqrelu_deepnorm"


def rope_tables(seq, dim):
    inv = 1.0 / (ROPE_THETA ** (jnp.arange(0, dim, 2, dtype=jnp.float32) / dim))
    ang = jnp.arange(seq, dtype=jnp.float32)[:, None] * inv[None, :]
    ang = jnp.concatenate([ang, ang], axis=-1)
    return jnp.cos(ang), jnp.sin(ang)


def apply_rope(x, cos, sin):
    half = x.shape[-1] // 2
    rot = jnp.concatenate([-x[..., half:], x[..., :half]], axis=-1)
    shape = (1, cos.shape[0]) + (1,) * (x.ndim - 3) + (cos.shape[1],)
    return x * cos.reshape(shape) + rot * sin.reshape(shape)


def layer_norm(x, g, b):
    xf = x.astype(jnp.float32)
    mu = jnp.mean(xf, axis=-1, keepdims=True)
    var = jnp.mean(jnp.square(xf - mu), axis=-1, keepdims=True)
    y = (xf - mu) * lax.rsqrt(var + LN_EPS) * g.astype(jnp.float32) + b.astype(jnp.float32)
    return y.astype(x.dtype)


def diff_attention(q, k, v, lam, subln_g, lambda_init):
    B, S, H, _, Dqk = q.shape
    nb = S // BLOCK
    scale = Dqk ** -0.5
    qb = q.reshape(B, nb, BLOCK, H, 2, Dqk).transpose(1, 0, 2, 3, 4, 5)
    k_pos = jnp.arange(S)

    def one_block(args):
        qi, i = args
        s = jnp.einsum('bqhmd,bkhmd->bhmqk', qi, k) * scale
        q_pos = i * BLOCK + jnp.arange(BLOCK)
        causal = k_pos[None, :] <= q_pos[:, None]
        p = jax.nn.softmax(jnp.where(causal, s, NEG), axis=-1)
        a = p[:, :, 0] - lam * p[:, :, 1]
        return jnp.einsum('bhqk,bkhd->bqhd', a, v)

    o = lax.map(one_block, (qb, jnp.arange(nb)))
    o = o.transpose(1, 0, 2, 3, 4).reshape(B, S, H, v.shape[-1])
    o = o * lax.rsqrt(jnp.mean(o * o, axis=-1, keepdims=True) + SUBLN_EPS) * subln_g.astype(jnp.float32)
    return o * (1.0 - lambda_init)


def dilated_window_attention(q, k, v, window, dilation):
    B, S, H, D = q.shape
    steps = window // dilation
    L = S // dilation
    Lp = ((L + BLOCK - 1) // BLOCK) * BLOCK
    nb = Lp // BLOCK

    def to_sub(t):
        t = t.reshape(B, L, dilation, H, D).transpose(0, 2, 3, 1, 4)
        t = jnp.pad(t, ((0, 0), (0, 0), (0, 0), (0, Lp - L), (0, 0)))
        return t.reshape(B, dilation, H, nb, BLOCK, D)

    qb, kb, vb = to_sub(q), to_sub(k), to_sub(v)
    pad_prev = ((0, 0), (0, 0), (0, 0), (1, 0), (0, 0), (0, 0))
    kwin = jnp.concatenate([jnp.pad(kb[:, :, :, :-1], pad_prev), kb], axis=4)
    vwin = jnp.concatenate([jnp.pad(vb[:, :, :, :-1], pad_prev), vb], axis=4)

    s = jnp.einsum('brhnqd,brhnkd->brhnqk', qb, kwin) * (D ** -0.5)
    qi = jnp.arange(BLOCK)[:, None]
    kj = jnp.arange(2 * BLOCK)[None, :]
    dist = qi + BLOCK - kj
    band = (dist >= 0) & (dist <= steps)
    key_exists = (jnp.arange(nb)[:, None, None] * BLOCK + kj[None] - BLOCK) >= 0
    mask = band[None] & key_exists
    s = jnp.where(mask, s, NEG)
    m = jnp.max(s, axis=-1, keepdims=True)
    e = jnp.exp(s - m)
    l = jnp.sum(e, axis=-1, keepdims=True)
    o = jnp.einsum('brhnqk,brhnkd->brhnqd', e, vwin) / l
    lse = m + jnp.log(l)

    def from_sub(t):
        c = t.shape[-1]
        t = t.reshape(B, dilation, H, Lp, c)[:, :, :, :L]
        return t.transpose(0, 3, 1, 2, 4).reshape(B, S, H, c)

    return from_sub(o), from_sub(lse)


def dilated_attention(q, k, v):
    outs, lses = [], []
    for window, dilation in DILATION_CONFIGS:
        o, lse = dilated_window_attention(q, k, v, window, dilation)
        outs.append(o)
        lses.append(lse)
    w = jax.nn.softmax(jnp.stack(lses, axis=0), axis=0)
    return jnp.sum(w * jnp.stack(outs, axis=0), axis=0)


def setup_inputs(seed: int = 0) -> dict:
    key = jax.random.key(seed)
    ks = jax.random.split(key, 16)
    f32 = jnp.float32
    x = jax.random.normal(ks[0], (BATCH, SEQ, D_MODEL), f32)
    w_in = jax.random.normal(ks[1], (DEPTH, D_MODEL, IN_COLS), f32) * D_MODEL ** -0.5
    col_scale = jnp.concatenate([
        jnp.ones((2 * DIFF_WIDTH,), f32), jnp.full((DIFF_WIDTH,), DEEPNORM_BETA, f32),
        jnp.ones((2 * DIL_WIDTH,), f32), jnp.full((DIL_WIDTH,), DEEPNORM_BETA, f32)])
    w_in = w_in * col_scale
    lambda_q1 = 0.1 * jax.random.normal(ks[2], (DEPTH, DIFF_QK_DIM), f32)
    lambda_k1 = 0.1 * jax.random.normal(ks[3], (DEPTH, DIFF_QK_DIM), f32)
    lambda_q2 = 0.1 * jax.random.normal(ks[4], (DEPTH, DIFF_QK_DIM), f32)
    lambda_k2 = 0.1 * jax.random.normal(ks[5], (DEPTH, DIFF_QK_DIM), f32)
    subln_g = 1.0 + 0.02 * jax.random.normal(ks[6], (DEPTH, HEAD_DIM), f32)
    w_out = jax.random.normal(ks[7], (DEPTH, MIX_WIDTH, D_MODEL), f32) * (MIX_WIDTH ** -0.5 * DEEPNORM_BETA)
    ln1_g = 1.0 + 0.02 * jax.random.normal(ks[8], (DEPTH, D_MODEL), f32)
    ln1_b = 0.02 * jax.random.normal(ks[9], (DEPTH, D_MODEL), f32)
    w_ff1 = jax.random.normal(ks[10], (DEPTH, D_MODEL, D_FF), f32) * (D_MODEL ** -0.5 * DEEPNORM_BETA)
    w_ff2 = jax.random.normal(ks[11], (DEPTH, D_FF, D_MODEL), f32) * (D_FF ** -0.5 * DEEPNORM_BETA)
    ln2_g = 1.0 + 0.02 * jax.random.normal(ks[12], (DEPTH, D_MODEL), f32)
    ln2_b = 0.02 * jax.random.normal(ks[13], (DEPTH, D_MODEL), f32)
    return {"x": x, "w_in": w_in, "lambda_q1": lambda_q1, "lambda_k1": lambda_k1,
            "lambda_q2": lambda_q2, "lambda_k2": lambda_k2, "subln_g": subln_g,
            "w_out": w_out, "ln1_g": ln1_g, "ln1_b": ln1_b, "w_ff1": w_ff1,
            "w_ff2": w_ff2, "ln2_g": ln2_g, "ln2_b": ln2_b}


def reference(x, w_in, lambda_q1, lambda_k1, lambda_q2, lambda_k2, subln_g, w_out,
              ln1_g, ln1_b, w_ff1, w_ff2, ln2_g, ln2_b):
    B, S, _ = x.shape
    f32 = jnp.float32
    cos_a, sin_a = rope_tables(S, DIFF_QK_DIM)
    cos_b, sin_b = rope_tables(S, HEAD_DIM)
    splits = [DIFF_WIDTH, 2 * DIFF_WIDTH, 3 * DIFF_WIDTH,
              3 * DIFF_WIDTH + DIL_WIDTH, 3 * DIFF_WIDTH + 2 * DIL_WIDTH]
    for l in range(DEPTH):
        lambda_init = 0.8 - 0.6 * math.exp(-0.3 * l)
        proj = jnp.einsum('bsd,dc->bsc', x, w_in[l]).astype(f32)
        q_a, k_a, v_a, q_b, k_b, v_b = jnp.split(proj, splits, axis=-1)
        q_a = apply_rope(q_a.reshape(B, S, N_HEADS_DIFF, 2, DIFF_QK_DIM), cos_a, sin_a)
        k_a = apply_rope(k_a.reshape(B, S, N_HEADS_DIFF, 2, DIFF_QK_DIM), cos_a, sin_a)
        v_a = v_a.reshape(B, S, N_HEADS_DIFF, HEAD_DIM)
        lam = (jnp.exp(jnp.sum(lambda_q1[l].astype(f32) * lambda_k1[l].astype(f32)))
               - jnp.exp(jnp.sum(lambda_q2[l].astype(f32) * lambda_k2[l].astype(f32)))
               + lambda_init)
        o_a = diff_attention(q_a, k_a, v_a, lam, subln_g[l], lambda_init)
        q_b = apply_rope(q_b.reshape(B, S, N_HEADS_DIL, HEAD_DIM), cos_b, sin_b)
        k_b = apply_rope(k_b.reshape(B, S, N_HEADS_DIL, HEAD_DIM), cos_b, sin_b)
        v_b = v_b.reshape(B, S, N_HEADS_DIL, HEAD_DIM)
        o_b = dilated_attention(q_b, k_b, v_b)
        mix = jnp.concatenate([o_a.reshape(B, S, DIFF_WIDTH),
                               o_b.reshape(B, S, DIL_WIDTH)], axis=-1).astype(x.dtype)
        attn_out = jnp.einsum('bsc,cd->bsd', mix, w_out[l])
        x = layer_norm(DEEPNORM_ALPHA * x + attn_out, ln1_g[l], ln1_b[l])
        hdn = jnp.square(jax.nn.relu(jnp.einsum('bsd,df->bsf', x, w_ff1[l])))
        ff_out = jnp.einsum('bsf,fd->bsd', hdn, w_ff2[l])
        x = layer_norm(DEEPNORM_ALPHA * x + ff_out, ln2_g[l], ln2_b[l])
    return x
```

```cpp
#include <hip/hip_runtime.h>
#include <hip/hip_cooperative_groups.h>
#include <cstdio>
namespace cg = cooperative_groups;
namespace pg8 {
#define PG8_LAS __attribute__((address_space(3)))
typedef unsigned short bf16_t;
typedef short bf16x8 __attribute__((ext_vector_type(8)));
typedef float f32x4 __attribute__((ext_vector_type(4)));
typedef unsigned u32x4 __attribute__((ext_vector_type(4)));
constexpr int BM = 256, BK = 64, HALF = 128, HTB = HALF * BK * 2  , STAGE_BYTES = 8 * HTB, NXCD = 8, WGM = 8;

__host__ __device__ __forceinline__ int lds_byte(int r, int c) { const int st = (r >> 4) * 2 + (c >> 5), rr = r & 15, cc = c & 31, ob = rr * 64 + cc * 2; return st * 1024 + (ob ^ (((ob >> 9) & 1) << 5)); }
__host__ __device__ __forceinline__ void stage_rc(int b, int& R, int& C) { const int st = b / 1024, sb = b % 1024, swz = sb ^ (((sb >> 9) & 1) << 5); R = (st >> 1) * 16 + swz / 64; C = (st & 1) * 32 + (swz % 64) / 2; }
__host__ __device__ __forceinline__ int perm32(int rho) { const int n = rho >> 4, i = rho & 15; return 8 * (i >> 2) + 4 * n + (i & 3); }

struct Unit { int pm, pn; };
struct Gemm { const bf16_t* A; const bf16_t* Bt; int M, N, K; };

struct StaticOrder {
    int nM, nN, nwg, G, c;
    __host__ __device__ void init(int M, int N, int G_, int c_) { nM = M / BM; nN = N / BM; nwg = nM * nN; G = G_; c = c_; }
    __host__ __device__ bool next(int i, Unit& u) const {
        const long L = (long)i * G + c; if (L >= nwg) return false;
        int wgid = (int)L; { const int q = nwg / NXCD, r = nwg % NXCD, xcd = wgid % NXCD, off = wgid / NXCD; wgid = (xcd < r ? xcd * (q + 1) : r * (q + 1) + (xcd - r) * q) + off; }
        const int nig = WGM * nN, gid = wgid / nig, fm = gid * WGM, gsz = (nM - fm) < WGM ? (nM - fm) : WGM;
        u.pm = fm + ((wgid % nig) % gsz); u.pn = (wgid % nig) / gsz; return true;
    }
    __device__ __forceinline__ void a_ready(const Unit&) const {}
    __device__ __forceinline__ void done(const Unit&) const {}
};

template <class Epi, class Sched, bool STAMP = false>
__device__ __forceinline__ void gemm_phase(PG8_LAS unsigned char* lds, const Gemm g, const Sched& S, const Epi& E, unsigned long long* stamps) {
    int tid_ = threadIdx.x; asm volatile("" : "+v"(tid_)); const int tid = tid_, wid = __builtin_amdgcn_readfirstlane(tid >> 6), lane = tid & 63, wr = wid >> 2, wc = wid & 3, fr = lane & 15, fq = lane >> 4;
    const int K = g.K, nt = K / BK;
    int ts_lo = 0, ts_hi = 0, nts = 0; const unsigned long long rt_entry = STAMP ? (unsigned long long)wall_clock64() : 0ull;
#define PG8_STAMP() do { if (STAMP && wid == 0 && nts < 64) { const unsigned long long _c = (unsigned long long)clock64(); \
        ts_lo = (lane == nts) ? (int)(unsigned)_c : ts_lo; ts_hi = (lane == nts) ? (int)(unsigned)(_c >> 32) : ts_hi; ++nts; } } while (0)
    PG8_STAMP();
    unsigned voffA[2], voffB[2];
#pragma unroll
    for (int i = 0; i < 2; ++i) { int R, C; stage_rc(tid * 16 + i * 8192, R, C); const int Rb = Epi::PERM ? ((R & ~31) + perm32(R & 31)) : R;
        voffA[i] = (unsigned)(R * K + C) * 2u; voffB[i] = (unsigned)(Rb * K + C) * 2u; }
    const size_t kstep = (size_t)(BK * 2);
    const size_t hstep = (size_t)HALF * K * 2;
    const size_t tstep = 2 * hstep;
    const unsigned ldsw = (unsigned)wid * 1024u;
    const int aoff = lds_byte(wr * 64 + fr, fq * 8), boff = lds_byte(wc * 32 + fr, fq * 8);
#define PG8_SA(b, h) (((b) * 2 + (h)) * HTB)
#define PG8_SB(b, h) ((4 + (b) * 2 + (h)) * HTB)
#define PG8_STAGE(bufoff, gbase, voff) do { _Pragma("unroll") for (int _i = 0; _i < 2; ++_i) \
        __builtin_amdgcn_global_load_lds((const unsigned*)((const char*)(gbase) + (voff)[_i]), (PG8_LAS unsigned*)(lds + (bufoff) + ldsw + _i * 8192), 16, 0, 0); } while (0)
#define PG8_LDA(dst, b, h) do { _Pragma("unroll") for (int m = 0; m < 4; ++m) _Pragma("unroll") for (int k = 0; k < 2; ++k) dst[m][k] = *(const PG8_LAS bf16x8*)(lds + PG8_SA(b, h) + aoff + m * 2048 + k * 1024); } while (0)
#define PG8_LDB(dst, b, h) do { _Pragma("unroll") for (int n = 0; n < 2; ++n) _Pragma("unroll") for (int k = 0; k < 2; ++k) dst[n][k] = *(const PG8_LAS bf16x8*)(lds + PG8_SB(b, h) + boff + n * 2048 + k * 1024); } while (0)
#define PG8_MMA(ai, bj, At, Bt) do { __builtin_amdgcn_s_setprio(1); _Pragma("unroll") for (int m = 0; m < 4; ++m) _Pragma("unroll") for (int n = 0; n < 2; ++n) _Pragma("unroll") for (int k = 0; k < 2; ++k) \
        acc[ai][bj][m][n] = __builtin_amdgcn_mfma_f32_16x16x32_bf16(Bt[n][k], At[m][k], acc[ai][bj][m][n], 0, 0, 0); __builtin_amdgcn_s_setprio(0); } while (0)
#define PG8_WAIT_V(n) asm volatile("s_waitcnt vmcnt(" #n ")" ::: "memory")
#define PG8_WAIT_L(n) asm volatile("s_waitcnt lgkmcnt(" #n ")" ::: "memory")
#define PG8_BAR __builtin_amdgcn_s_barrier()
#define PG8_SCHED __builtin_amdgcn_sched_barrier(0)
    Unit cur, nxt; int ui = 0;
    if (!S.next(0, cur)) return;
    f32x4 acc[2][2][4][2];
#pragma unroll
    for (int a = 0; a < 2; ++a)
#pragma unroll
        for (int b = 0; b < 2; ++b)
#pragma unroll
            for (int m = 0; m < 4; ++m)
#pragma unroll
                for (int n = 0; n < 2; ++n) acc[a][b][m][n] = (f32x4){0.f, 0.f, 0.f, 0.f};
    bf16x8 At[4][2], B0[2][2], B1[2][2];
    const char* cA = (const char*)g.A + (size_t)cur.pm * tstep; const char* cB = (const char*)g.Bt + (size_t)cur.pn * tstep;
    S.a_ready(cur);
    PG8_STAGE(PG8_SB(0, 0), cB, voffB); PG8_STAGE(PG8_SA(0, 0), cA, voffA); PG8_STAGE(PG8_SB(0, 1), cB + hstep, voffB); PG8_STAGE(PG8_SA(0, 1), cA + hstep, voffA);
    if (wr == 1) PG8_BAR;
    PG8_WAIT_V(4); PG8_BAR;
    PG8_STAGE(PG8_SB(1, 0), cB + kstep, voffB); PG8_STAGE(PG8_SA(1, 0), cA + kstep, voffA); PG8_STAGE(PG8_SB(1, 1), cB + hstep + kstep, voffB);
    PG8_WAIT_V(6); PG8_BAR;
    PG8_STAMP();
    for (;;) {
        const bool has_next = S.next(ui + 1, nxt);
        const char* nA = has_next ? (const char*)g.A + (size_t)nxt.pm * tstep : cA; const char* nB = has_next ? (const char*)g.Bt + (size_t)nxt.pn * tstep : cB;
        for (int t = 0; t < nt; t += 2) {
            const bool last = (t == nt - 2);
            const char* a1 = cA + (size_t)(t + 1) * kstep;
            const char* a2 = last ? nA : cA + (size_t)(t + 2) * kstep; const char* b2 = last ? nB : cB + (size_t)(t + 2) * kstep;
            const char* a3 = a2 + kstep; const char* b3 = b2 + kstep;
            if (last && has_next) S.a_ready(nxt);
            PG8_LDB(B0, 0, 0); PG8_SCHED; PG8_LDA(At, 0, 0); PG8_STAGE(PG8_SA(1, 1), a1 + hstep, voffA);
            PG8_WAIT_L(8); PG8_BAR; PG8_WAIT_L(0); PG8_MMA(0, 0, At, B0); PG8_BAR; PG8_SCHED;
            PG8_LDB(B1, 0, 1); PG8_STAGE(PG8_SB(0, 0), b2, voffB);
            PG8_BAR; PG8_WAIT_L(0); PG8_MMA(0, 1, At, B1); PG8_BAR;
            PG8_LDA(At, 0, 1); PG8_STAGE(PG8_SA(0, 0), a2, voffA);
            PG8_BAR; PG8_WAIT_L(0); PG8_MMA(1, 0, At, B0); PG8_BAR; PG8_SCHED;
            PG8_STAGE(PG8_SB(0, 1), b2 + hstep, voffB);
            PG8_WAIT_V(6); PG8_BAR; PG8_MMA(1, 1, At, B1); PG8_BAR;
            PG8_LDB(B0, 1, 0); PG8_SCHED; PG8_LDA(At, 1, 0); PG8_STAGE(PG8_SA(0, 1), a2 + hstep, voffA);
            PG8_WAIT_L(8); PG8_BAR; PG8_WAIT_L(0); PG8_MMA(0, 0, At, B0); PG8_BAR; PG8_SCHED;
            PG8_LDB(B1, 1, 1); PG8_STAGE(PG8_SB(1, 0), b3, voffB);
            PG8_BAR; PG8_WAIT_L(0); PG8_MMA(0, 1, At, B1); PG8_BAR;
            PG8_LDA(At, 1, 1); PG8_STAGE(PG8_SA(1, 0), a3, voffA);
            PG8_BAR; PG8_WAIT_L(0); PG8_MMA(1, 0, At, B0); PG8_BAR; PG8_SCHED;
            PG8_STAGE(PG8_SB(1, 1), b3 + hstep, voffB);
            PG8_WAIT_V(6); PG8_BAR; PG8_MMA(1, 1, At, B1); PG8_BAR;
        }
        PG8_STAMP();
        if constexpr (!Epi::AFTER_DRAIN) { E(acc, cur, wr, wc, fr, fq); S.done(cur); }
        PG8_STAMP();
        if (!has_next) break;
#pragma unroll
        for (int a = 0; a < 2; ++a)
#pragma unroll
            for (int b = 0; b < 2; ++b)
#pragma unroll
                for (int m = 0; m < 4; ++m)
#pragma unroll
                    for (int n = 0; n < 2; ++n) acc[a][b][m][n] = (f32x4){0.f, 0.f, 0.f, 0.f};
        cur = nxt; cA = nA; cB = nB; ++ui;
    }
    PG8_WAIT_V(0);
    if (wr == 0) PG8_BAR;
    PG8_BAR;
    if constexpr (Epi::AFTER_DRAIN) { E.fused(acc, cur, wr, wc, fr, fq, lds, wid, lane); S.done(cur); }
    PG8_STAMP();
    if (STAMP && wid == 0) { stamps[lane] = lane < nts ? (((unsigned long long)(unsigned)ts_hi << 32) | (unsigned)ts_lo) : 0ull;
        if (lane == 62) stamps[62] = rt_entry; if (lane == 63) stamps[63] = (unsigned long long)wall_clock64(); }
#undef PG8_STAMP
#undef PG8_SA
#undef PG8_SB
#undef PG8_STAGE
#undef PG8_LDA
#undef PG8_LDB
#undef PG8_MMA
#undef PG8_WAIT_V
#undef PG8_WAIT_L
#undef PG8_BAR
#undef PG8_SCHED
}
}

using pg8::bf16_t; using pg8::bf16x8; using pg8::f32x4; using pg8::u32x4; using pg8::Unit;
#define LAS __attribute__((address_space(3)))
#define DI __device__ __forceinline__
DI int opaque_tid() { int t = threadIdx.x; asm volatile("" : "+v"(t)); return t; }
typedef float f32x16 __attribute__((ext_vector_type(16)));
typedef short s16x4 __attribute__((ext_vector_type(4)));
typedef float f32x2 __attribute__((ext_vector_type(2)));
typedef unsigned u32x2 __attribute__((ext_vector_type(2)));
typedef __bf16 bf2_t __attribute__((ext_vector_type(2)));

constexpr int TOK = 32768, DM = 2048, SEQ = 2048, DFF = 8192;
constexpr size_t MiB = (size_t)1 << 20;
constexpr size_t WS_WQK = 0, WS_WV = 16 * MiB, WS_WOUT = 24 * MiB, WS_WFF1 = 32 * MiB, WS_WFF2 = 64 * MiB, WS_TABA = 96 * MiB, WS_TABB = 96 * MiB + 512 * 1024,
                 WS_X1B = 98 * MiB, WS_XB = 226 * MiB, WS_QK = 354 * MiB, WS_VT = 610 * MiB, WS_HDN = 226 * MiB, WS_END = 738 * MiB;
constexpr int LDS_BYTES = 131072;
constexpr float DN_ALPHA = 1.189207115002721f;

DI unsigned pk_bf16(float lo, float hi) { f32x2 v = {lo, hi}; bf2_t b = __builtin_convertvector(v, bf2_t); return __builtin_bit_cast(unsigned, b); }
DI float bf_lo(unsigned w) { return __uint_as_float(w << 16); }
DI float bf_hi(unsigned w) { return __uint_as_float(w & 0xffff0000u); }
DI float xhalf_max(float v) { auto r = __builtin_amdgcn_permlane32_swap(__float_as_uint(v), __float_as_uint(v), false, false); return fmaxf(__uint_as_float(r[0]), __uint_as_float(r[1])); }
DI float xhalf_sum(float v) { auto r = __builtin_amdgcn_permlane32_swap(__float_as_uint(v), __float_as_uint(v), false, false); return __uint_as_float(r[0]) + __uint_as_float(r[1]); }
#define MFMA32(a, b, c) __builtin_amdgcn_mfma_f32_32x32x16_bf16((a), (b), (c), 0, 0, 0)

struct Params {
    const float* x; const float* w_in; const float* lq1; const float* lk1; const float* lq2; const float* lk2; const float* subg; const float* w_out;
    const float* ln1g; const float* ln1b; const float* w_ff1; const float* w_ff2; const float* ln2g; const float* ln2b; float* out; unsigned char* ws;
};

struct EpiRope {
    static constexpr bool PERM = true, AFTER_DRAIN = false;
    bf16_t* QK; const float* tabA; const float* tabB;
    DI void operator()(const f32x4 (&acc)[2][2][4][2], const Unit& u, int wr, int wc, int fr, int fq) const {
        const bool dil = (u.pn >> 2) >= 2;
        const int half = dil ? 64 : 32;
        const int lc0 = dil ? (128 * (wc >> 1) + 32 * (wc & 1) + 8 * fq) : (64 * wc + 8 * fq);
        const int ri0 = dil ? (32 * (wc & 1) + 8 * fq) : (8 * fq);
        const float* tab = dil ? tabB : tabA;
        const int row0 = u.pm * 256 + wr * 64 + fr;
#pragma unroll
        for (int ai = 0; ai < 2; ++ai)
#pragma unroll
            for (int m = 0; m < 4; ++m) {
                const int row = row0 + ai * 128 + m * 16, pos = row & (SEQ - 1);
                const f32x4* tp = (const f32x4*)(tab + ((size_t)pos * half + ri0) * 2);
                f32x4 tt[4]; tt[0] = tp[0]; tt[1] = tp[1]; tt[2] = tp[2]; tt[3] = tp[3];
                float lo[8], hi[8];
#pragma unroll
                for (int n = 0; n < 2; ++n)
#pragma unroll
                    for (int j = 0; j < 4; ++j) {
                        const int idx = 4 * n + j; const float c = tt[idx >> 1][(idx & 1) * 2], s = tt[idx >> 1][(idx & 1) * 2 + 1];
                        const float x0 = acc[ai][0][m][n][j], x1 = acc[ai][1][m][n][j];
                        lo[idx] = x0 * c - x1 * s; hi[idx] = x1 * c + x0 * s;
                    }
                bf16_t* rp = QK + (size_t)row * 4096 + u.pn * 256 + lc0;
                u32x4 w0, w1;
                w0.x = pk_bf16(lo[0], lo[1]); w0.y = pk_bf16(lo[2], lo[3]); w0.z = pk_bf16(lo[4], lo[5]); w0.w = pk_bf16(lo[6], lo[7]);
                w1.x = pk_bf16(hi[0], hi[1]); w1.y = pk_bf16(hi[2], hi[3]); w1.z = pk_bf16(hi[4], hi[5]); w1.w = pk_bf16(hi[6], hi[7]);
                *(u32x4*)rp = w0; *(u32x4*)(rp + half) = w1;
            }
    }
};
template <int ACT  > struct EpiBf {
    static constexpr bool PERM = true, AFTER_DRAIN = false;
    bf16_t* O; int ldc;
    DI void operator()(const f32x4 (&acc)[2][2][4][2], const Unit& u, int wr, int wc, int fr, int fq) const {
        const int row0 = u.pm * 256 + wr * 64 + fr, col0 = u.pn * 256 + wc * 32 + 8 * fq;
#pragma unroll
        for (int ai = 0; ai < 2; ++ai)
#pragma unroll
            for (int m = 0; m < 4; ++m) {
                bf16_t* rowp = O + (size_t)(row0 + ai * 128 + m * 16) * ldc + col0;
#pragma unroll
                for (int bj = 0; bj < 2; ++bj) {
                    f32x4 v0 = acc[ai][bj][m][0], v1 = acc[ai][bj][m][1];
                    if (ACT == 1) {
#pragma unroll
                        for (int j = 0; j < 4; ++j) { const float a = fmaxf(v0[j], 0.f), b = fmaxf(v1[j], 0.f); v0[j] = a * a; v1[j] = b * b; }
                    }
                    u32x4 w; w.x = pk_bf16(v0[0], v0[1]); w.y = pk_bf16(v0[2], v0[3]); w.z = pk_bf16(v1[0], v1[1]); w.w = pk_bf16(v1[2], v1[3]);
                    *(u32x4*)(rowp + bj * 128) = w;
                }
            }
    }
};
struct EpiRes {
    static constexpr bool PERM = false, AFTER_DRAIN = false;
    const float* R; float* C;
    DI void operator()(const f32x4 (&acc)[2][2][4][2], const Unit& u, int wr, int wc, int fr, int fq) const {
        const int row0 = u.pm * 256 + wr * 64 + fr, col0 = u.pn * 256 + wc * 32 + 4 * fq;
#pragma unroll
        for (int ai = 0; ai < 2; ++ai)
#pragma unroll
            for (int m = 0; m < 4; ++m) {
                const size_t off = (size_t)(row0 + ai * 128 + m * 16) * DM + col0;
#pragma unroll
                for (int bj = 0; bj < 2; ++bj)
#pragma unroll
                    for (int n = 0; n < 2; ++n) {
                        const f32x4 rv = *(const f32x4*)(R + off + bj * 128 + n * 16);
                        *(f32x4*)(C + off + bj * 128 + n * 16) = rv * DN_ALPHA + acc[ai][bj][m][n];
                    }
            }
    }
};

DI void tconv_tile(LAS unsigned char* lds, const float* src, int N, int K, bf16_t* dst, int p0, int c0, int k0) {
    const int tid = opaque_tid();
    LAS bf16_t* tile = (LAS bf16_t*)lds;
#pragma unroll
    for (int i = 0; i < 4; ++i) {
        const int u = tid + 512 * i, kl = u >> 3, c4 = (u & 7) * 4;
        const f32x4 v = *(const f32x4*)(src + (size_t)(k0 + kl) * N + c0 + c4);
        const unsigned w0 = pk_bf16(v[0], v[1]), w1 = pk_bf16(v[2], v[3]);
        tile[(c4 + 0) * 264 + kl] = (bf16_t)(w0 & 0xffffu); tile[(c4 + 1) * 264 + kl] = (bf16_t)(w0 >> 16);
        tile[(c4 + 2) * 264 + kl] = (bf16_t)(w1 & 0xffffu); tile[(c4 + 3) * 264 + kl] = (bf16_t)(w1 >> 16);
    }
    __syncthreads();
#pragma unroll
    for (int i = 0; i < 2; ++i) {
        const int ch = tid + 512 * i, pr = ch >> 5, kc = (ch & 31) * 8;
        const u32x4 w = *(const LAS u32x4*)(lds + pr * 528 + kc * 2);
        *(u32x4*)(dst + (size_t)(p0 + pr) * K + k0 + kc) = w;
    }
    __syncthreads();
}
DI void sincos_d(double r, float& s, float& c) {
    const double r2 = r * r;
    double ts = 1.0, tc = 1.0, ss = 1.0, cs = 1.0;
#pragma unroll
    for (int n = 1; n <= 13; ++n) { tc = -tc * r2 * (1.0 / (double)((2 * n - 1) * (2 * n))); ts = -ts * r2 * (1.0 / (double)((2 * n) * (2 * n + 1))); cs += tc; ss += ts; }
    s = (float)(r * ss); c = (float)cs;
}
DI void p0_phase(LAS unsigned char* lds, const Params& p) {
    const int G = gridDim.x, bid = blockIdx.x, tid = opaque_tid();
    const size_t gtid = (size_t)bid * 512 + tid, gth = (size_t)G * 512;
    unsigned char* ws = p.ws;
    {
        const f32x4* xs = (const f32x4*)p.x; u32x4* xd = (u32x4*)(ws + WS_XB);
        for (size_t i = gtid; i < (size_t)TOK * DM / 8; i += gth) {
            const f32x4 a = xs[2 * i], b = xs[2 * i + 1]; u32x4 w;
            w.x = pk_bf16(a[0], a[1]); w.y = pk_bf16(a[2], a[3]); w.z = pk_bf16(b[0], b[1]); w.w = pk_bf16(b[2], b[3]); xd[i] = w;
        }
    }
    {
        float* tabA = (float*)(ws + WS_TABA); float* tabB = (float*)(ws + WS_TABB);
        for (size_t idx = gtid; idx < (size_t)SEQ * 96; idx += gth) {
            const int pos = (int)(idx / 96), j = (int)(idx % 96);
            const bool dil = j >= 32; const int i = dil ? j - 32 : j;
            const float ex = dil ? (float)(2 * i) / 128.0f : (float)(2 * i) / 64.0f;
            const float inv = 1.0f / powf(10000.0f, ex);
            const float ang = (float)pos * inv;
            const double a = (double)ang; const double kk = rint(a * 0.15915494309189535);
            const double rr = a - kk * 6.283185307179586;
            float s, c; sincos_d(rr, s, c);
            float* d = dil ? tabB + ((size_t)pos * 64 + i) * 2 : tabA + ((size_t)pos * 32 + i) * 2;
            d[0] = c; d[1] = s;
        }
    }
    for (int t = bid; t < 6144; t += G) {
        const float* src; bf16_t* dst; int N, K, p0, c0, k0;
        if (t < 1024) {
            src = p.w_in; dst = (bf16_t*)(ws + WS_WQK); N = 6144; K = 2048; p0 = (t >> 3) * 32; k0 = (t & 7) * 256;
            const int pn = p0 >> 8, pp = p0 & 255, bj = pp >> 7, wc = (pp >> 5) & 3;
            const int lc = (pn >> 2) < 2 ? (64 * wc + 32 * bj) : (128 * (wc >> 1) + 64 * bj + 32 * (wc & 1));
            const int l = pn * 256 + lc; c0 = l < 2048 ? l : l + 1024;
        } else if (t < 1536) {
            const int tt = t - 1024; src = p.w_in; dst = (bf16_t*)(ws + WS_WV); N = 6144; K = 2048; p0 = (tt >> 3) * 32; k0 = (tt & 7) * 256;
            c0 = p0 < 1024 ? 2048 + p0 : 4096 + p0;
        } else if (t < 2048) {
            const int tt = t - 1536; src = p.w_out; dst = (bf16_t*)(ws + WS_WOUT); N = 2048; K = 2048; p0 = (tt >> 3) * 32; k0 = (tt & 7) * 256; c0 = p0;
        } else if (t < 4096) {
            const int tt = t - 2048; src = p.w_ff1; dst = (bf16_t*)(ws + WS_WFF1); N = 8192; K = 2048; p0 = (tt >> 3) * 32; k0 = (tt & 7) * 256; c0 = p0;
        } else {
            const int tt = t - 4096; src = p.w_ff2; dst = (bf16_t*)(ws + WS_WFF2); N = 2048; K = 8192; p0 = (tt >> 5) * 32; k0 = (tt & 31) * 256; c0 = p0;
        }
        tconv_tile(lds, src, N, K, dst, p0, c0, k0);
    }
}

constexpr int A_KP = 272, A_VP = 136, A_KB = 64 * A_KP, A_VB = 128 * A_VP, A_BUF = A_KB + A_VB;
constexpr float LOG2E = 1.4426950408889634f;

template <bool DIL>
DI void attn_item(LAS unsigned char* lds, const bf16_t* Qb, const bf16_t* Kb, const bf16_t* VTb, bf16_t* Mb, int qb, float lam, const float* subg) {
    const int tid = opaque_tid(), lane = tid & 63, w = __builtin_amdgcn_readfirstlane(tid >> 6), r = lane & 31, h = lane >> 5;
    const int q0w = qb * 256 + w * 32;
    const int nt = 4 * qb + 4;
    const int k_row0 = tid >> 4, k_c = tid & 15, v_row0 = tid >> 3, v_c = tid & 7;
    const bf16_t* kg = Kb + (size_t)k_row0 * 4096 + k_c * 8;
    const bf16_t* vg = VTb + (size_t)v_row0 * 32768 + v_c * 8;
    const unsigned k_l = k_row0 * A_KP + k_c * 16, v_l = A_KB + v_row0 * A_VP + v_c * 16;
    const unsigned ka_off = r * A_KP + h * 16, va_off = A_KB + r * A_VP + h * 8;
    constexpr int NPASS = DIL ? 1 : 2, NKS = DIL ? 8 : 4;
    const float cs = (DIL ? 0.08838834764831845f : 0.125f) * LOG2E;
    u32x2 o1pk[4][4];
#pragma unroll
    for (int pass = 0; pass < NPASS; ++pass) {
        bf16x8 qf[NKS];
#pragma unroll
        for (int ks = 0; ks < NKS; ++ks) qf[ks] = *(const bf16x8*)(Qb + (size_t)(q0w + r) * 4096 + pass * 64 + ks * 16 + h * 8);
        f32x16 oacc[4];
#pragma unroll
        for (int db = 0; db < 4; ++db)
#pragma unroll
            for (int i = 0; i < 16; ++i) oacc[db][i] = 0.f;
        float m_run = -1e30f, l_run = 0.f;
        u32x4 kr[2], vr[2];
#define A_LOAD(kt) do { _Pragma("unroll") for (int i_ = 0; i_ < 2; ++i_) { \
            kr[i_] = *(const u32x4*)(kg + (size_t)((kt) * 64 + i_ * 32) * 4096); \
            vr[i_] = *(const u32x4*)(vg + (size_t)(i_ * 64) * 32768 + (kt) * 64); } } while (0)
#define A_STORE(buf) do { LAS unsigned char* b_ = lds + (buf) * A_BUF; _Pragma("unroll") for (int i_ = 0; i_ < 2; ++i_) { \
            *(LAS u32x4*)(b_ + k_l + i_ * 32 * A_KP) = kr[i_]; \
            u32x2 lo_ = {vr[i_].x, vr[i_].y}, hi_ = {vr[i_].z, vr[i_].w}; \
            *(LAS u32x2*)(b_ + v_l + i_ * 64 * A_VP) = lo_; *(LAS u32x2*)(b_ + v_l + i_ * 64 * A_VP + 8) = hi_; } } while (0)
        A_LOAD(0); A_STORE(0); __syncthreads();
        for (int kt = 0; kt < nt; ++kt) {
            const int cur = kt & 1;
            if (kt + 1 < nt) A_LOAD(kt + 1);
            if (kt * 64 <= q0w + 31) {
                LAS unsigned char* bp = lds + cur * A_BUF;
                f32x16 s0, s1;
#pragma unroll
                for (int i = 0; i < 16; ++i) { s0[i] = 0.f; s1[i] = 0.f; }
#pragma unroll
                for (int ks = 0; ks < NKS; ++ks) {
                    const bf16x8 a0 = *(const LAS bf16x8*)(bp + ka_off + pass * 128 + ks * 32);
                    const bf16x8 a1 = *(const LAS bf16x8*)(bp + ka_off + 32 * A_KP + pass * 128 + ks * 32);
                    s0 = MFMA32(a0, qf[ks], s0); s1 = MFMA32(a1, qf[ks], s1);
                }
                const int base = q0w + r - 4 * h - kt * 64;
                float mx = -1e30f;
#pragma unroll
                for (int kb = 0; kb < 2; ++kb)
#pragma unroll
                    for (int i = 0; i < 16; ++i) {
                        const int dlt = base - (32 * kb + (i & 3) + 8 * (i >> 2));
                        const float sv = kb ? s1[i] : s0[i];
                        float t;
                        if (DIL) {
                            const int cnt = (dlt <= 128 ? 1 : 0) + ((((dlt & 3) == 0) && dlt <= 512) ? 1 : 0) + (((dlt & 15) == 0) ? 1 : 0);
                            const float lg = cnt == 3 ? 1.5849625007211562f : (cnt == 2 ? 1.0f : 0.0f);
                            t = (dlt >= 0 && cnt > 0) ? __builtin_fmaf(sv, cs, lg) : -1e30f;
                        } else {
                            t = dlt >= 0 ? sv * cs : -1e30f;
                        }
                        if (kb) s1[i] = t; else s0[i] = t;
                        mx = fmaxf(mx, t);
                    }
                mx = xhalf_max(mx);
                const float m_new = fmaxf(m_run, mx);
                const float alpha = __builtin_amdgcn_exp2f(m_run - m_new);
                m_run = m_new; l_run *= alpha;
#pragma unroll
                for (int db = 0; db < 4; ++db)
#pragma unroll
                    for (int i = 0; i < 16; ++i) oacc[db][i] *= alpha;
                float ls = 0.f;
#pragma unroll
                for (int i = 0; i < 16; ++i) { const float p0 = __builtin_amdgcn_exp2f(s0[i] - m_new), p1 = __builtin_amdgcn_exp2f(s1[i] - m_new); s0[i] = p0; s1[i] = p1; ls += p0 + p1; }
                l_run += ls;
#pragma unroll
                for (int kb = 0; kb < 2; ++kb)
#pragma unroll
                    for (int s = 0; s < 2; ++s) {
                        u32x4 pw;
                        if (kb) { pw.x = pk_bf16(s1[8 * s + 0], s1[8 * s + 1]); pw.y = pk_bf16(s1[8 * s + 2], s1[8 * s + 3]); pw.z = pk_bf16(s1[8 * s + 4], s1[8 * s + 5]); pw.w = pk_bf16(s1[8 * s + 6], s1[8 * s + 7]); }
                        else    { pw.x = pk_bf16(s0[8 * s + 0], s0[8 * s + 1]); pw.y = pk_bf16(s0[8 * s + 2], s0[8 * s + 3]); pw.z = pk_bf16(s0[8 * s + 4], s0[8 * s + 5]); pw.w = pk_bf16(s0[8 * s + 6], s0[8 * s + 7]); }
                        const bf16x8 pb = __builtin_bit_cast(bf16x8, pw);
#pragma unroll
                        for (int db = 0; db < 4; ++db) {
                            const s16x4 lo = *(const LAS s16x4*)(bp + va_off + db * 32 * A_VP + (32 * kb + 16 * s) * 2);
                            const s16x4 hi = *(const LAS s16x4*)(bp + va_off + db * 32 * A_VP + (32 * kb + 16 * s) * 2 + 16);
                            const bf16x8 va = __builtin_shufflevector(lo, hi, 0, 1, 2, 3, 4, 5, 6, 7);
                            oacc[db] = MFMA32(va, pb, oacc[db]);
                        }
                    }
            }
            if (kt + 1 < nt) A_STORE(cur ^ 1);
            __syncthreads();
        }
#undef A_LOAD
#undef A_STORE
        const float l_tot = xhalf_sum(l_run);
        bf16_t* mp = Mb + (size_t)(q0w + r) * DM + 4 * h;
        if (DIL) {
            const float inv = 1.0f / l_tot;
#pragma unroll
            for (int db = 0; db < 4; ++db)
#pragma unroll
                for (int g = 0; g < 4; ++g) {
                    u32x2 wv; wv.x = pk_bf16(oacc[db][4 * g] * inv, oacc[db][4 * g + 1] * inv); wv.y = pk_bf16(oacc[db][4 * g + 2] * inv, oacc[db][4 * g + 3] * inv);
                    *(u32x2*)(mp + 32 * db + 8 * g) = wv;
                }
        } else if (pass == 0) {
            const float inv = 1.0f / l_tot;
#pragma unroll
            for (int db = 0; db < 4; ++db)
#pragma unroll
                for (int g = 0; g < 4; ++g) {
                    o1pk[db][g].x = pk_bf16(oacc[db][4 * g] * inv, oacc[db][4 * g + 1] * inv); o1pk[db][g].y = pk_bf16(oacc[db][4 * g + 2] * inv, oacc[db][4 * g + 3] * inv);
                }
        } else {
            const float inv2 = lam / l_tot;
            float ss = 0.f;
#pragma unroll
            for (int db = 0; db < 4; ++db)
#pragma unroll
                for (int g = 0; g < 4; ++g) {
                    const float a0 = bf_lo(o1pk[db][g].x) - oacc[db][4 * g] * inv2, a1 = bf_hi(o1pk[db][g].x) - oacc[db][4 * g + 1] * inv2;
                    const float a2 = bf_lo(o1pk[db][g].y) - oacc[db][4 * g + 2] * inv2, a3 = bf_hi(o1pk[db][g].y) - oacc[db][4 * g + 3] * inv2;
                    oacc[db][4 * g] = a0; oacc[db][4 * g + 1] = a1; oacc[db][4 * g + 2] = a2; oacc[db][4 * g + 3] = a3;
                    ss += a0 * a0 + a1 * a1 + a2 * a2 + a3 * a3;
                }
            ss = xhalf_sum(ss);
            const float rn = __builtin_amdgcn_rsqf(ss * (1.0f / 128.0f) + 1e-5f) * 0.8f;
#pragma unroll
            for (int db = 0; db < 4; ++db)
#pragma unroll
                for (int g = 0; g < 4; ++g) {
                    const f32x4 gv = *(const f32x4*)(subg + 32 * db + 8 * g + 4 * h);
                    u32x2 wv; wv.x = pk_bf16(oacc[db][4 * g] * rn * gv[0], oacc[db][4 * g + 1] * rn * gv[1]); wv.y = pk_bf16(oacc[db][4 * g + 2] * rn * gv[2], oacc[db][4 * g + 3] * rn * gv[3]);
                    *(u32x2*)(mp + 32 * db + 8 * g) = wv;
                }
        }
    }
}
DI void attn_phase(LAS unsigned char* lds, const Params& p) {
    float d1 = 0.f, d2 = 0.f;
    for (int i = 0; i < 64; ++i) { d1 += p.lq1[i] * p.lk1[i]; d2 += p.lq2[i] * p.lk2[i]; }
    const float lam = __expf(d1) - __expf(d2) + 0.2f;
    const bf16_t* QK = (const bf16_t*)(p.ws + WS_QK); const bf16_t* VT = (const bf16_t*)(p.ws + WS_VT); bf16_t* MIX = (bf16_t*)(p.ws + WS_XB);
    for (int idx = blockIdx.x; idx < 2048; idx += gridDim.x) {
        const int i = idx >> 8, c = idx & 255, type = i >> 2, jj = i & 3, bh = c >> 1, set = c & 1;
        const int qb = ((set ? 0x1256 : 0x0347) >> (4 * jj)) & 15;
        const int b = bh >> 3, hh = bh & 7;
        const bf16_t* Qb = QK + (size_t)b * SEQ * 4096 + type * 2048 + hh * 128;
        const bf16_t* Kb = Qb + 1024;
        const bf16_t* VTb = VT + (size_t)(type * 1024 + hh * 128) * TOK + b * SEQ;
        bf16_t* Mb = MIX + (size_t)b * SEQ * DM + type * 1024 + hh * 128;
        if (type) attn_item<true>(lds, Qb, Kb, VTb, Mb, qb, lam, p.subg);
        else attn_item<false>(lds, Qb, Kb, VTb, Mb, qb, lam, p.subg);
    }
}

DI float wave_sum(float v) {
#pragma unroll
    for (int o = 32; o >= 1; o >>= 1) v += __shfl_xor(v, o);
    return v;
}
DI void ln_phase(float* io, bf16_t* ob, const float* g, const float* b) {
    const int tid = opaque_tid(); const int lane = tid & 63, gw = blockIdx.x * 8 + (tid >> 6), nw = gridDim.x * 8;
    for (int row = gw; row < TOK; row += nw) {
        float* rp = io + (size_t)row * DM + lane * 4;
        f32x4 v[8]; float s = 0.f;
#pragma unroll
        for (int i = 0; i < 8; ++i) { v[i] = *(const f32x4*)(rp + i * 256); s += v[i][0] + v[i][1] + v[i][2] + v[i][3]; }
        const float mean = wave_sum(s) * (1.0f / DM);
        float q = 0.f;
#pragma unroll
        for (int i = 0; i < 8; ++i)
#pragma unroll
            for (int j = 0; j < 4; ++j) { const float d = v[i][j] - mean; q += d * d; }
        const float rstd = 1.0f / sqrtf(wave_sum(q) * (1.0f / DM) + 1e-5f);
#pragma unroll
        for (int i = 0; i < 8; ++i) {
            const f32x4 gv = *(const f32x4*)(g + i * 256 + lane * 4), bv = *(const f32x4*)(b + i * 256 + lane * 4);
            f32x4 y;
#pragma unroll
            for (int j = 0; j < 4; ++j) y[j] = (v[i][j] - mean) * rstd * gv[j] + bv[j];
            *(f32x4*)(rp + i * 256) = y;
            if (ob) { u32x2 wv; wv.x = pk_bf16(y[0], y[1]); wv.y = pk_bf16(y[2], y[3]); *(u32x2*)(ob + (size_t)row * DM + i * 256 + lane * 4) = wv; }
        }
    }
}

__global__ void __launch_bounds__(512, 2) fwd_megakernel(Params p) {
    extern __shared__ __attribute__((aligned(16))) unsigned char lds_raw[];
    LAS unsigned char* lds = (LAS unsigned char*)lds_raw;
    cg::grid_group grid = cg::this_grid();
    const int G = gridDim.x, bid = blockIdx.x;
    unsigned char* ws = p.ws;
    bf16_t* XB = (bf16_t*)(ws + WS_XB); bf16_t* QK = (bf16_t*)(ws + WS_QK); bf16_t* VT = (bf16_t*)(ws + WS_VT);
    bf16_t* X1B = (bf16_t*)(ws + WS_X1B); bf16_t* HDN = (bf16_t*)(ws + WS_HDN);

    p0_phase(lds, p);
    grid.sync();
    {
        pg8::Gemm g{XB, (const bf16_t*)(ws + WS_WQK), TOK, 4096, DM}; pg8::StaticOrder S; S.init(TOK, 4096, G, bid);
        EpiRope E{QK, (const float*)(ws + WS_TABA), (const float*)(ws + WS_TABB)};
        pg8::gemm_phase<EpiRope, pg8::StaticOrder>(lds, g, S, E, nullptr);
    }
    {
        pg8::Gemm g{(const bf16_t*)(ws + WS_WV), XB, 2048, TOK, DM}; pg8::StaticOrder S; S.init(2048, TOK, G, bid);
        EpiBf<0> E{VT, TOK};
        pg8::gemm_phase<EpiBf<0>, pg8::StaticOrder>(lds, g, S, E, nullptr);
    }
    grid.sync();
    attn_phase(lds, p);
    grid.sync();
    {
        pg8::Gemm g{XB, (const bf16_t*)(ws + WS_WOUT), TOK, DM, DM}; pg8::StaticOrder S; S.init(TOK, DM, G, bid);
        EpiRes E{p.x, p.out};
        pg8::gemm_phase<EpiRes, pg8::StaticOrder>(lds, g, S, E, nullptr);
    }
    grid.sync();
    ln_phase(p.out, X1B, p.ln1g, p.ln1b);
    grid.sync();
    {
        pg8::Gemm g{X1B, (const bf16_t*)(ws + WS_WFF1), TOK, DFF, DM}; pg8::StaticOrder S; S.init(TOK, DFF, G, bid);
        EpiBf<1> E{HDN, DFF};
        pg8::gemm_phase<EpiBf<1>, pg8::StaticOrder>(lds, g, S, E, nullptr);
    }
    grid.sync();
    {
        pg8::Gemm g{HDN, (const bf16_t*)(ws + WS_WFF2), TOK, DM, DFF}; pg8::StaticOrder S; S.init(TOK, DM, G, bid);
        EpiRes E{p.out, p.out};
        pg8::gemm_phase<EpiRes, pg8::StaticOrder>(lds, g, S, E, nullptr);
    }
    grid.sync();
    ln_phase(p.out, nullptr, p.ln2g, p.ln2b);
}

extern "C" void kernel_launch(void* const* d_in, const int* in_sizes, int n_in, void* d_out, int out_size, void* d_ws, size_t ws_size, hipStream_t stream) {
    static int grid = 0;
    if (grid == 0) {
        if (n_in != 14 || in_sizes[0] != TOK * DM || out_size != TOK * DM || ws_size < WS_END) {
            fprintf(stderr, "kernel_launch: unexpected shapes (n_in %d, in0 %d, out %d, ws %zu)\n", n_in, n_in > 0 ? in_sizes[0] : -1, out_size, ws_size); grid = -1; return; }
        int dev = 0, cus = 0, per_cu = 0;
        (void)hipGetDevice(&dev); (void)hipDeviceGetAttribute(&cus, hipDeviceAttributeMultiprocessorCount, dev);
        if (hipFuncSetAttribute((const void*)fwd_megakernel, hipFuncAttributeMaxDynamicSharedMemorySize, LDS_BYTES) != hipSuccess) { fprintf(stderr, "kernel_launch: hipFuncSetAttribute failed\n"); grid = -1; return; }
        if (hipOccupancyMaxActiveBlocksPerMultiprocessor(&per_cu, (const void*)fwd_megakernel, 512, LDS_BYTES) != hipSuccess || per_cu < 1) { fprintf(stderr, "kernel_launch: occupancy query gave %d\n", per_cu); per_cu = 1; }
        (void)hipGetLastError();
        grid = cus * per_cu;
    }
    if (grid < 0) return;
    Params p{};
    p.x = (const float*)d_in[0]; p.w_in = (const float*)d_in[1]; p.lq1 = (const float*)d_in[2]; p.lk1 = (const float*)d_in[3]; p.lq2 = (const float*)d_in[4]; p.lk2 = (const float*)d_in[5];
    p.subg = (const float*)d_in[6]; p.w_out = (const float*)d_in[7]; p.ln1g = (const float*)d_in[8]; p.ln1b = (const float*)d_in[9]; p.w_ff1 = (const float*)d_in[10]; p.w_ff2 = (const float*)d_in[11];
    p.ln2g = (const float*)d_in[12]; p.ln2b = (const float*)d_in[13]; p.out = (float*)d_out; p.ws = (unsigned char*)d_ws;
    void* args[] = {&p};
    hipError_t e = hipLaunchCooperativeKernel((const void*)fwd_megakernel, dim3(grid), dim3(512), args, LDS_BYTES, stream);
    if (e != hipSuccess) fprintf(stderr, "kernel_launch: cooperative launch failed: %s (grid %d)\n", hipGetErrorString(e), grid);
}
```

```cpp
#include <hip/hip_runtime.h>
#include <hip/hip_cooperative_groups.h>
#include <cstdio>
namespace cg = cooperative_groups;
namespace pg8 {
#define PG8_LAS __attribute__((address_space(3)))
typedef unsigned short bf16_t;
typedef short bf16x8 __attribute__((ext_vector_type(8)));
typedef float f32x4 __attribute__((ext_vector_type(4)));
typedef unsigned u32x4 __attribute__((ext_vector_type(4)));
constexpr int BM = 256, BK = 64, HALF = 128, HTB = HALF * BK * 2  , STAGE_BYTES = 8 * HTB, NXCD = 8, WGM = 8;

__host__ __device__ __forceinline__ int lds_byte(int r, int c) { const int st = (r >> 4) * 2 + (c >> 5), rr = r & 15, cc = c & 31, ob = rr * 64 + cc * 2; return st * 1024 + (ob ^ (((ob >> 9) & 1) << 5)); }
__host__ __device__ __forceinline__ void stage_rc(int b, int& R, int& C) { const int st = b / 1024, sb = b % 1024, swz = sb ^ (((sb >> 9) & 1) << 5); R = (st >> 1) * 16 + swz / 64; C = (st & 1) * 32 + (swz % 64) / 2; }
__host__ __device__ __forceinline__ int perm32(int rho) { const int n = rho >> 4, i = rho & 15; return 8 * (i >> 2) + 4 * n + (i & 3); }

struct Unit { int pm, pn; };
struct Gemm { const bf16_t* A; const bf16_t* Bt; int M, N, K; };

struct StaticOrder {
    int nM, nN, nwg, G, c;
    __host__ __device__ void init(int M, int N, int G_, int c_) { nM = M / BM; nN = N / BM; nwg = nM * nN; G = G_; c = c_; }
    __host__ __device__ bool next(int i, Unit& u) const {
        const long L = (long)i * G + c; if (L >= nwg) return false;
        int wgid = (int)L; { const int q = nwg / NXCD, r = nwg % NXCD, xcd = wgid % NXCD, off = wgid / NXCD; wgid = (xcd < r ? xcd * (q + 1) : r * (q + 1) + (xcd - r) * q) + off; }
        const int nig = WGM * nN, gid = wgid / nig, fm = gid * WGM, gsz = (nM - fm) < WGM ? (nM - fm) : WGM;
        u.pm = fm + ((wgid % nig) % gsz); u.pn = (wgid % nig) / gsz; return true;
    }
    __device__ __forceinline__ void a_ready(const Unit&) const {}
    __device__ __forceinline__ void done(const Unit&) const {}
};

typedef int v8i_t __attribute__((ext_vector_type(8)));
typedef int v4i_t __attribute__((ext_vector_type(4)));
__device__ __forceinline__ v8i_t cat8(bf16x8 a, bf16x8 b) { return __builtin_shufflevector(__builtin_bit_cast(v4i_t, a), __builtin_bit_cast(v4i_t, b), 0, 1, 2, 3, 4, 5, 6, 7); }
template <class Epi, class Sched, bool FP8 = false, bool STAMP = false>
__device__ __forceinline__ void gemm_phase(PG8_LAS unsigned char* lds, const Gemm g, const Sched& S, const Epi& E, unsigned long long* stamps) {
    int tid_ = threadIdx.x; asm volatile("" : "+v"(tid_)); const int tid = tid_, wid = __builtin_amdgcn_readfirstlane(tid >> 6), lane = tid & 63, wr = wid >> 2, wc = wid & 3, fr = lane & 15, fq = lane >> 4;
    const int K = g.K, nt = K / BK;
    int ts_lo = 0, ts_hi = 0, nts = 0; const unsigned long long rt_entry = STAMP ? (unsigned long long)wall_clock64() : 0ull;
#define PG8_STAMP() do { if (STAMP && wid == 0 && nts < 64) { const unsigned long long _c = (unsigned long long)clock64(); \
        ts_lo = (lane == nts) ? (int)(unsigned)_c : ts_lo; ts_hi = (lane == nts) ? (int)(unsigned)(_c >> 32) : ts_hi; ++nts; } } while (0)
    PG8_STAMP();
    unsigned voffA[2], voffB[2];
#pragma unroll
    for (int i = 0; i < 2; ++i) { int R, C; stage_rc(tid * 16 + i * 8192, R, C); const int Rb = Epi::PERM ? ((R & ~31) + perm32(R & 31)) : R;
        voffA[i] = (unsigned)(R * K + C) * 2u; voffB[i] = (unsigned)(Rb * K + C) * 2u; }
    const size_t kstep = (size_t)(BK * 2);
    const size_t hstep = (size_t)HALF * K * 2;
    const size_t tstep = 2 * hstep;
    const unsigned ldsw = (unsigned)wid * 1024u;
    const int aoff = lds_byte(wr * 64 + fr, fq * 8), boff = lds_byte(wc * 32 + fr, fq * 8);
#define PG8_SA(b, h) (((b) * 2 + (h)) * HTB)
#define PG8_SB(b, h) ((4 + (b) * 2 + (h)) * HTB)
#define PG8_STAGE(bufoff, gbase, voff) do { _Pragma("unroll") for (int _i = 0; _i < 2; ++_i) \
        __builtin_amdgcn_global_load_lds((const unsigned*)((const char*)(gbase) + (voff)[_i]), (PG8_LAS unsigned*)(lds + (bufoff) + ldsw + _i * 8192), 16, 0, 0); } while (0)
#define PG8_LDA(dst, b, h) do { _Pragma("unroll") for (int m = 0; m < 4; ++m) _Pragma("unroll") for (int k = 0; k < 2; ++k) dst[m][k] = *(const PG8_LAS bf16x8*)(lds + PG8_SA(b, h) + aoff + m * 2048 + k * 1024); } while (0)
#define PG8_LDB(dst, b, h) do { _Pragma("unroll") for (int n = 0; n < 2; ++n) _Pragma("unroll") for (int k = 0; k < 2; ++k) dst[n][k] = *(const PG8_LAS bf16x8*)(lds + PG8_SB(b, h) + boff + n * 2048 + k * 1024); } while (0)
#define PG8_MMA(ai, bj, At, Bt) do { __builtin_amdgcn_s_setprio(1); _Pragma("unroll") for (int m = 0; m < 4; ++m) _Pragma("unroll") for (int n = 0; n < 2; ++n) { \
        if constexpr (FP8) { asm volatile("v_mfma_scale_f32_16x16x128_f8f6f4 %0, %1, %2, %0, %3, %3 op_sel_hi:[0,0,0]" : "+v"(acc[ai][bj][m][n]) : "v"(cat8(Bt[n][0], Bt[n][1])), "v"(cat8(At[m][0], At[m][1])), "v"(f8scale)); } \
        else { _Pragma("unroll") for (int k = 0; k < 2; ++k) acc[ai][bj][m][n] = __builtin_amdgcn_mfma_f32_16x16x32_bf16(Bt[n][k], At[m][k], acc[ai][bj][m][n], 0, 0, 0); } } \
        __builtin_amdgcn_s_setprio(0); } while (0)
#define PG8_WAIT_V(n) asm volatile("s_waitcnt vmcnt(" #n ")" ::: "memory")
#define PG8_WAIT_L(n) asm volatile("s_waitcnt lgkmcnt(" #n ")" ::: "memory")
#define PG8_BAR __builtin_amdgcn_s_barrier()
#define PG8_SCHED __builtin_amdgcn_sched_barrier(0)
    Unit cur, nxt; int ui = 0;
    if (!S.next(0, cur)) return;
    f32x4 acc[2][2][4][2];
#pragma unroll
    for (int a = 0; a < 2; ++a)
#pragma unroll
        for (int b = 0; b < 2; ++b)
#pragma unroll
            for (int m = 0; m < 4; ++m)
#pragma unroll
                for (int n = 0; n < 2; ++n) acc[a][b][m][n] = (f32x4){0.f, 0.f, 0.f, 0.f};
    bf16x8 At[4][2], B0[2][2], B1[2][2];
    const int f8scale = 0x7f7f7f7f;
    const char* cA = (const char*)g.A + (size_t)cur.pm * tstep; const char* cB = (const char*)g.Bt + (size_t)cur.pn * tstep;
    S.a_ready(cur);
    PG8_STAGE(PG8_SB(0, 0), cB, voffB); PG8_STAGE(PG8_SA(0, 0), cA, voffA); PG8_STAGE(PG8_SB(0, 1), cB + hstep, voffB); PG8_STAGE(PG8_SA(0, 1), cA + hstep, voffA);
    if (wr == 1) PG8_BAR;
    PG8_WAIT_V(4); PG8_BAR;
    PG8_STAGE(PG8_SB(1, 0), cB + kstep, voffB); PG8_STAGE(PG8_SA(1, 0), cA + kstep, voffA); PG8_STAGE(PG8_SB(1, 1), cB + hstep + kstep, voffB);
    PG8_WAIT_V(6); PG8_BAR;
    PG8_STAMP();
    for (;;) {
        const bool has_next = S.next(ui + 1, nxt);
        const char* nA = has_next ? (const char*)g.A + (size_t)nxt.pm * tstep : cA; const char* nB = has_next ? (const char*)g.Bt + (size_t)nxt.pn * tstep : cB;
        for (int t = 0; t < nt; t += 2) {
            const bool last = (t == nt - 2);
            const char* a1 = cA + (size_t)(t + 1) * kstep;
            const char* a2 = last ? nA : cA + (size_t)(t + 2) * kstep; const char* b2 = last ? nB : cB + (size_t)(t + 2) * kstep;
            const char* a3 = a2 + kstep; const char* b3 = b2 + kstep;
            if (last && has_next) S.a_ready(nxt);
            const bool fresh = (t == 0) && (ui > 0);
            PG8_LDB(B0, 0, 0); PG8_SCHED; PG8_LDA(At, 0, 0); PG8_STAGE(PG8_SA(1, 1), a1 + hstep, voffA);
            PG8_WAIT_L(8); PG8_BAR; PG8_WAIT_L(0); PG8_MMA(0, 0, At, B0); PG8_BAR; PG8_SCHED;
            PG8_LDB(B1, 0, 1); PG8_STAGE(PG8_SB(0, 0), b2, voffB);
            PG8_BAR; PG8_WAIT_L(0); PG8_MMA(0, 1, At, B1); PG8_BAR;
            PG8_LDA(At, 0, 1); PG8_STAGE(PG8_SA(0, 0), a2, voffA);
            PG8_BAR; PG8_WAIT_L(0); PG8_MMA(1, 0, At, B0); PG8_BAR; PG8_SCHED;
            PG8_STAGE(PG8_SB(0, 1), b2 + hstep, voffB);
            asm volatile("s_waitcnt vmcnt(24)\n\ts_cmp_lg_u32 %0, 0\n\ts_cbranch_scc1 1f\n\ts_waitcnt vmcnt(6)\n1:" :: "s"(__builtin_amdgcn_readfirstlane((int)fresh)) : "scc", "memory");
            PG8_BAR; PG8_MMA(1, 1, At, B1); PG8_BAR;
            PG8_LDB(B0, 1, 0); PG8_SCHED; PG8_LDA(At, 1, 0); PG8_STAGE(PG8_SA(0, 1), a2 + hstep, voffA);
            PG8_WAIT_L(8); PG8_BAR; PG8_WAIT_L(0); PG8_MMA(0, 0, At, B0); PG8_BAR; PG8_SCHED;
            PG8_LDB(B1, 1, 1); PG8_STAGE(PG8_SB(1, 0), b3, voffB);
            PG8_BAR; PG8_WAIT_L(0); PG8_MMA(0, 1, At, B1); PG8_BAR;
            PG8_LDA(At, 1, 1); PG8_STAGE(PG8_SA(1, 0), a3, voffA);
            PG8_BAR; PG8_WAIT_L(0); PG8_MMA(1, 0, At, B0); PG8_BAR; PG8_SCHED;
            PG8_STAGE(PG8_SB(1, 1), b3 + hstep, voffB);
            PG8_WAIT_V(6); PG8_BAR; PG8_MMA(1, 1, At, B1); PG8_BAR;
        }
        PG8_STAMP();
        if constexpr (FP8) { asm volatile("s_nop 15\n\ts_nop 15" ::: "memory"); }
        PG8_SCHED; if (has_next) PG8_STAGE(PG8_SA(1, 1), nA + kstep + hstep, voffA); PG8_SCHED;
        if constexpr (!Epi::AFTER_DRAIN) { E(acc, cur, wr, wc, fr, fq); S.done(cur); }
        PG8_STAMP();
        if (!has_next) break;
#pragma unroll
        for (int a = 0; a < 2; ++a)
#pragma unroll
            for (int b = 0; b < 2; ++b)
#pragma unroll
                for (int m = 0; m < 4; ++m)
#pragma unroll
                    for (int n = 0; n < 2; ++n) acc[a][b][m][n] = (f32x4){0.f, 0.f, 0.f, 0.f};
        cur = nxt; cA = nA; cB = nB; ++ui;
    }
    PG8_WAIT_V(0);
    if (wr == 0) PG8_BAR;
    PG8_BAR;
    if constexpr (Epi::AFTER_DRAIN) { E.fused(acc, cur, wr, wc, fr, fq, lds, wid, lane); S.done(cur); }
    PG8_STAMP();
    if (STAMP && wid == 0) { stamps[lane] = lane < nts ? (((unsigned long long)(unsigned)ts_hi << 32) | (unsigned)ts_lo) : 0ull;
        if (lane == 62) stamps[62] = rt_entry; if (lane == 63) stamps[63] = (unsigned long long)wall_clock64(); }
#undef PG8_STAMP
#undef PG8_SA
#undef PG8_SB
#undef PG8_STAGE
#undef PG8_LDA
#undef PG8_LDB
#undef PG8_MMA
#undef PG8_WAIT_V
#undef PG8_WAIT_L
#undef PG8_BAR
#undef PG8_SCHED
}
}
#define LAS __attribute__((address_space(3)))

#define XB_TMO      128
#define XB_XCNT(j)  (256  + 64 * (j))
#define XB_XSUB(j)  (1280 + 64 * (j))
#define XB_XGEN(j)  (2304 + 64 * (j))
#define XB_TOP      3328
#define XB_TOPGEN   3392
#define XCD_BAR_WORDS 3456
#define XB_SPIN_CAP (1u << 22)

__device__ __forceinline__ unsigned xb_ld(unsigned* p)              { return __hip_atomic_load(p, __ATOMIC_RELAXED, __HIP_MEMORY_SCOPE_AGENT); }
__device__ __forceinline__ unsigned xb_add(unsigned* p, unsigned v) { return __hip_atomic_fetch_add(p, v, __ATOMIC_RELAXED, __HIP_MEMORY_SCOPE_AGENT); }
__device__ __forceinline__ unsigned xb_xcc_id() { return (unsigned)__builtin_amdgcn_s_getreg((3 << 11) | 20) & 0xFu; }
#define XB_SPIN(cond, bar) do { unsigned _sp = 0; while (cond) { __builtin_amdgcn_s_sleep(1); \
    if ((++_sp & 255u) == 0u) { if (xb_ld(&(bar)[XB_TMO])) break; if (_sp > XB_SPIN_CAP) { atomicAdd(&(bar)[XB_TMO], 1u); break; } } } } while (0)

struct XcdBarrier {
    unsigned* bar; unsigned x;
    volatile LAS unsigned* st;
};

__device__ __forceinline__ XcdBarrier xcd_barrier_post(unsigned* bar, volatile LAS unsigned* st) {
    XcdBarrier b; b.bar = bar; b.x = xb_xcc_id(); b.st = st;
    if (threadIdx.x == 0) (void)xb_add(&bar[XB_XCNT(b.x)], 1u);
    return b;
}
__device__ __forceinline__ void xcd_barrier_complete(unsigned* bar, unsigned x, unsigned& nloc, unsigned& nx) {
    const unsigned G = gridDim.x * gridDim.y * gridDim.z;
    unsigned sum, cnt, mine, sp = 0u;
    for (;;) {
        sum = 0u; cnt = 0u; mine = 0u;
#pragma unroll
        for (unsigned j = 0; j < 16; ++j) { const unsigned c = xb_ld(&bar[XB_XCNT(j)]); sum += c; cnt += (c > 0u) ? 1u : 0u; mine = (j == x) ? c : mine; }
        if (sum == G) break;
        __builtin_amdgcn_s_sleep(1);
        if ((++sp & 255u) == 0u) { if (xb_ld(&bar[XB_TMO])) break; if (sp > XB_SPIN_CAP) { atomicAdd(&bar[XB_TMO], 1u); break; } }
    }
    nloc = mine > 0u ? mine : 1u; nx = cnt > 0u ? cnt : 1u;
}

__device__ __forceinline__ void xcd_barrier(const XcdBarrier& b) {
    asm volatile("s_waitcnt vmcnt(0)" ::: "memory");
    __syncthreads();
    if (threadIdx.x == 0) {
        unsigned* bar = b.bar;
        __builtin_amdgcn_s_waitcnt(0);
        unsigned nloc = b.st[0], nx = b.st[1];
        if (nloc == 0u) { xcd_barrier_complete(bar, b.x, nloc, nx); b.st[0] = nloc; b.st[1] = nx; }
        const unsigned old = xb_add(&bar[XB_XSUB(b.x)], 1u);
        const unsigned gen = old / nloc;
        if (old + 1u == (gen + 1u) * nloc) {
            __builtin_amdgcn_fence(__ATOMIC_RELEASE, "agent");
            asm volatile("s_waitcnt vmcnt(0)" ::: "memory");
            const unsigned og = xb_add(&bar[XB_TOP], 1u);
            const unsigned tg = og / nx;
            if (og + 1u == (tg + 1u) * nx) xb_add(&bar[XB_TOPGEN], 1u);
            else XB_SPIN(xb_ld(&bar[XB_TOPGEN]) == tg, bar);
            __builtin_amdgcn_fence(__ATOMIC_ACQUIRE, "agent");
            xb_add(&bar[XB_XGEN(b.x)], 1u);
            asm volatile("s_waitcnt vmcnt(0)" ::: "memory");
        } else {
            XB_SPIN(xb_ld(&bar[XB_XGEN(b.x)]) == gen, bar);
            __builtin_amdgcn_fence(__ATOMIC_ACQUIRE, "agent");
            asm volatile("s_waitcnt vmcnt(0)" ::: "memory");
        }
    }
    __syncthreads();
}


using pg8::bf16_t; using pg8::bf16x8; using pg8::f32x4; using pg8::u32x4; using pg8::Unit;
#define DI __device__ __forceinline__
DI int opaque_tid() { int t = threadIdx.x; asm volatile("" : "+v"(t)); return t; }
typedef float f32x16 __attribute__((ext_vector_type(16)));
typedef short s16x4 __attribute__((ext_vector_type(4)));
typedef float f32x2 __attribute__((ext_vector_type(2)));
typedef unsigned u32x2 __attribute__((ext_vector_type(2)));
typedef __bf16 bf2_t __attribute__((ext_vector_type(2)));

constexpr int TOK = 32768, DM = 2048, SEQ = 2048, DFF = 8192;
constexpr size_t MiB = (size_t)1 << 20;
constexpr size_t WS_WQK = 0, WS_WV = 16 * MiB, WS_WOUT = 24 * MiB, WS_WFF1 = 32 * MiB, WS_WFF2 = 64 * MiB, WS_TABA = 96 * MiB, WS_TABB = 96 * MiB + 512 * 1024,
                 WS_STATS = 97 * MiB + 512 * 1024, WS_BAR = 97 * MiB + 768 * 1024, WS_X1B = 98 * MiB, WS_XB = 226 * MiB, WS_QK = 354 * MiB, WS_VT = 610 * MiB, WS_HDN = 226 * MiB, WS_END = 738 * MiB;
constexpr int LDS_BYTES = 131072;
constexpr int REP_P0 = 1, REP_P1 = 1, REP_ATT = 1, REP_P3 = 1, REP_LN1 = 1, REP_P5 = 1;
constexpr float DN_ALPHA = 1.189207115002721f;

DI unsigned pk_bf16(float lo, float hi) { f32x2 v = {lo, hi}; bf2_t b = __builtin_convertvector(v, bf2_t); return __builtin_bit_cast(unsigned, b); }
DI float bf_lo(unsigned w) { return __uint_as_float(w << 16); }
DI float bf_hi(unsigned w) { return __uint_as_float(w & 0xffff0000u); }
DI float xhalf_max(float v) { auto r = __builtin_amdgcn_permlane32_swap(__float_as_uint(v), __float_as_uint(v), false, false); return fmaxf(__uint_as_float(r[0]), __uint_as_float(r[1])); }
DI float xhalf_sum(float v) { auto r = __builtin_amdgcn_permlane32_swap(__float_as_uint(v), __float_as_uint(v), false, false); return __uint_as_float(r[0]) + __uint_as_float(r[1]); }
#define MFMA32(a, b, c) __builtin_amdgcn_mfma_f32_32x32x16_bf16((a), (b), (c), 0, 0, 0)

struct Params {
    const float* x; const float* w_in; const float* lq1; const float* lk1; const float* lq2; const float* lk2; const float* subg; const float* w_out;
    const float* ln1g; const float* ln1b; const float* w_ff1; const float* w_ff2; const float* ln2g; const float* ln2b; float* out; unsigned char* ws;
};

struct EpiRope {
    static constexpr bool PERM = true, AFTER_DRAIN = false;
    bf16_t* QK; const float* tabA; const float* tabB;
    DI void operator()(const f32x4 (&acc)[2][2][4][2], const Unit& u, int, int, int, int) const {
        const int t_ = opaque_tid(), wid_ = __builtin_amdgcn_readfirstlane(t_ >> 6), wr = wid_ >> 2, wc = wid_ & 3, fr = t_ & 15, fq = (t_ & 63) >> 4;
        const bool dil = (u.pn >> 2) >= 2;
        const int half = dil ? 64 : 32;
        const int lc0 = dil ? (128 * (wc >> 1) + 32 * (wc & 1) + 8 * fq) : (64 * wc + 8 * fq);
        const int ri0 = dil ? (32 * (wc & 1) + 8 * fq) : (8 * fq);
        const float* tab = dil ? tabB : tabA;
        const int row0 = u.pm * 256 + wr * 64 + fr;
        const int region = u.pn >> 2;
        const float osc = region == 0 ? 0.125f * 1.4426950408889634f : (region == 2 ? 0.08838834764831845f * 1.4426950408889634f : 1.0f);
        f32x4 tt[2][4];
        {
            const f32x4* tp = (const f32x4*)(tab + ((size_t)(row0 & (SEQ - 1)) * half + ri0) * 2);
            tt[0][0] = tp[0]; tt[0][1] = tp[1]; tt[0][2] = tp[2]; tt[0][3] = tp[3];
        }
#pragma unroll
        for (int it = 0; it < 8; ++it) {
            const int ai = it >> 2, m = it & 3;
            const int row = row0 + ai * 128 + m * 16;
            if (it + 1 < 8) {
                const int nrow = row0 + ((it + 1) >> 2) * 128 + ((it + 1) & 3) * 16;
                const f32x4* tp = (const f32x4*)(tab + ((size_t)(nrow & (SEQ - 1)) * half + ri0) * 2);
                tt[(it + 1) & 1][0] = tp[0]; tt[(it + 1) & 1][1] = tp[1]; tt[(it + 1) & 1][2] = tp[2]; tt[(it + 1) & 1][3] = tp[3];
            }
            float lo[8], hi[8];
#pragma unroll
            for (int n = 0; n < 2; ++n)
#pragma unroll
                for (int j = 0; j < 4; ++j) {
                    const int idx = 4 * n + j; const float c = tt[it & 1][idx >> 1][(idx & 1) * 2], s = tt[it & 1][idx >> 1][(idx & 1) * 2 + 1];
                    const float x0 = acc[ai][0][m][n][j], x1 = acc[ai][1][m][n][j];
                    lo[idx] = (x0 * c - x1 * s) * osc; hi[idx] = (x1 * c + x0 * s) * osc;
                }
            bf16_t* rp = QK + (size_t)row * 4096 + u.pn * 256 + lc0;
            u32x4 w0, w1;
            w0.x = pk_bf16(lo[0], lo[1]); w0.y = pk_bf16(lo[2], lo[3]); w0.z = pk_bf16(lo[4], lo[5]); w0.w = pk_bf16(lo[6], lo[7]);
            w1.x = pk_bf16(hi[0], hi[1]); w1.y = pk_bf16(hi[2], hi[3]); w1.z = pk_bf16(hi[4], hi[5]); w1.w = pk_bf16(hi[6], hi[7]);
            *(u32x4*)rp = w0; *(u32x4*)(rp + half) = w1;
        }
    }
};
template <int ACT  > struct EpiBf {
    static constexpr bool PERM = true, AFTER_DRAIN = false;
    bf16_t* O; int ldc;
    DI void operator()(const f32x4 (&acc)[2][2][4][2], const Unit& u, int, int, int, int) const {
        const int t_ = opaque_tid(), wid_ = __builtin_amdgcn_readfirstlane(t_ >> 6), wr = wid_ >> 2, wc = wid_ & 3, fr = t_ & 15, fq = (t_ & 63) >> 4;
        const int row0 = u.pm * 256 + wr * 64 + fr, col0 = u.pn * 256 + wc * 32 + 8 * fq;
#pragma unroll
        for (int ai = 0; ai < 2; ++ai)
#pragma unroll
            for (int m = 0; m < 4; ++m) {
                bf16_t* rowp = O + (size_t)(row0 + ai * 128 + m * 16) * ldc + col0;
#pragma unroll
                for (int bj = 0; bj < 2; ++bj) {
                    f32x4 v0 = acc[ai][bj][m][0], v1 = acc[ai][bj][m][1];
                    if (ACT == 1) {
#pragma unroll
                        for (int j = 0; j < 4; ++j) { const float a = fmaxf(v0[j], 0.f), b = fmaxf(v1[j], 0.f); v0[j] = a * a; v1[j] = b * b; }
                    }
                    u32x4 w; w.x = pk_bf16(v0[0], v0[1]); w.y = pk_bf16(v0[2], v0[3]); w.z = pk_bf16(v1[0], v1[1]); w.w = pk_bf16(v1[2], v1[3]);
                    *(u32x4*)(rowp + bj * 128) = w;
                }
            }
    }
};
struct EpiRes {
    static constexpr bool PERM = false, AFTER_DRAIN = false;
    const float* R; float* C; float scale;
    DI void operator()(const f32x4 (&acc)[2][2][4][2], const Unit& u, int, int, int, int) const {
        const int t_ = opaque_tid(), wid_ = __builtin_amdgcn_readfirstlane(t_ >> 6), wr = wid_ >> 2, wc = wid_ & 3, fr = t_ & 15, fq = (t_ & 63) >> 4;
        const int row0 = u.pm * 256 + wr * 64 + fr, col0 = u.pn * 256 + wc * 32 + 4 * fq;
#pragma unroll
        for (int ai = 0; ai < 2; ++ai)
#pragma unroll
            for (int m = 0; m < 4; ++m) {
                const size_t off = (size_t)(row0 + ai * 128 + m * 16) * DM + col0;
#pragma unroll
                for (int bj = 0; bj < 2; ++bj)
#pragma unroll
                    for (int n = 0; n < 2; ++n) {
                        const f32x4 rv = *(const f32x4*)(R + off + bj * 128 + n * 16);
                        *(f32x4*)(C + off + bj * 128 + n * 16) = rv * DN_ALPHA + acc[ai][bj][m][n] * scale;
                    }
            }
    }
};

struct EpiResBf {
    static constexpr bool PERM = true, AFTER_DRAIN = false;
    const float* R; bf16_t* Y;
    DI void operator()(const f32x4 (&acc)[2][2][4][2], const Unit& u, int, int, int, int) const {
        const int t_ = opaque_tid(), wid_ = __builtin_amdgcn_readfirstlane(t_ >> 6), wr = wid_ >> 2, wc = wid_ & 3, fr = t_ & 15, fq = (t_ & 63) >> 4;
        const int row0 = u.pm * 256 + wr * 64 + fr, col0 = u.pn * 256 + wc * 32 + 8 * fq;
#pragma unroll
        for (int ai = 0; ai < 2; ++ai)
#pragma unroll
            for (int m = 0; m < 4; ++m) {
                const size_t off = (size_t)(row0 + ai * 128 + m * 16) * DM + col0;
#pragma unroll
                for (int bj = 0; bj < 2; ++bj) {
                    const f32x4 r0 = *(const f32x4*)(R + off + bj * 128), r1 = *(const f32x4*)(R + off + bj * 128 + 4);
                    const f32x4 v0 = r0 * DN_ALPHA + acc[ai][bj][m][0], v1 = r1 * DN_ALPHA + acc[ai][bj][m][1];
                    u32x4 w; w.x = pk_bf16(v0[0], v0[1]); w.y = pk_bf16(v0[2], v0[3]); w.z = pk_bf16(v1[0], v1[1]); w.w = pk_bf16(v1[2], v1[3]);
                    *(u32x4*)(Y + off + bj * 128) = w;
                }
            }
    }
};
struct EpiResLnBf {
    static constexpr bool PERM = true, AFTER_DRAIN = false;
    const bf16_t* Y1; const float* stats; const float* g; const float* b; bf16_t* Y;
    DI void operator()(const f32x4 (&acc)[2][2][4][2], const Unit& u, int, int, int, int) const {
        const int t_ = opaque_tid(), wid_ = __builtin_amdgcn_readfirstlane(t_ >> 6), wr = wid_ >> 2, wc = wid_ & 3, fr = t_ & 15, fq = (t_ & 63) >> 4;
        const int row0 = u.pm * 256 + wr * 64 + fr, col0 = u.pn * 256 + wc * 32 + 8 * fq;
        f32x4 gg[2][2], bb[2][2];
#pragma unroll
        for (int bj = 0; bj < 2; ++bj)
#pragma unroll
            for (int n = 0; n < 2; ++n) { gg[bj][n] = *(const f32x4*)(g + col0 + bj * 128 + 4 * n); bb[bj][n] = *(const f32x4*)(b + col0 + bj * 128 + 4 * n); }
#pragma unroll
        for (int ai = 0; ai < 2; ++ai)
#pragma unroll
            for (int m = 0; m < 4; ++m) {
                const int row = row0 + ai * 128 + m * 16;
                const size_t off = (size_t)row * DM + col0;
                const f32x2 st = *(const f32x2*)(stats + 2 * row);
#pragma unroll
                for (int bj = 0; bj < 2; ++bj) {
                    const u32x4 yw = *(const u32x4*)(Y1 + off + bj * 128);
                    f32x4 v0, v1;
#pragma unroll
                    for (int j = 0; j < 2; ++j) {
                        v0[2 * j] = (bf_lo(yw[j]) - st[0]) * st[1] * gg[bj][0][2 * j] + bb[bj][0][2 * j];
                        v0[2 * j + 1] = (bf_hi(yw[j]) - st[0]) * st[1] * gg[bj][0][2 * j + 1] + bb[bj][0][2 * j + 1];
                        v1[2 * j] = (bf_lo(yw[2 + j]) - st[0]) * st[1] * gg[bj][1][2 * j] + bb[bj][1][2 * j];
                        v1[2 * j + 1] = (bf_hi(yw[2 + j]) - st[0]) * st[1] * gg[bj][1][2 * j + 1] + bb[bj][1][2 * j + 1];
                    }
                    v0 = v0 * DN_ALPHA + acc[ai][bj][m][0]; v1 = v1 * DN_ALPHA + acc[ai][bj][m][1];
                    u32x4 w; w.x = pk_bf16(v0[0], v0[1]); w.y = pk_bf16(v0[2], v0[3]); w.z = pk_bf16(v1[0], v1[1]); w.w = pk_bf16(v1[2], v1[3]);
                    *(u32x4*)(Y + off + bj * 128) = w;
                }
            }
    }
};

DI void tconv_tile(LAS unsigned char* lds, const float* src, int N, int K, bf16_t* dst, int p0, int c0, int k0) {
    const int tid = opaque_tid();
    LAS bf16_t* tile = (LAS bf16_t*)lds;
#pragma unroll
    for (int i = 0; i < 4; ++i) {
        const int u = tid + 512 * i, kl = u >> 3, c4 = (u & 7) * 4;
        const f32x4 v = *(const f32x4*)(src + (size_t)(k0 + kl) * N + c0 + c4);
        const unsigned w0 = pk_bf16(v[0], v[1]), w1 = pk_bf16(v[2], v[3]);
        tile[(c4 + 0) * 264 + kl] = (bf16_t)(w0 & 0xffffu); tile[(c4 + 1) * 264 + kl] = (bf16_t)(w0 >> 16);
        tile[(c4 + 2) * 264 + kl] = (bf16_t)(w1 & 0xffffu); tile[(c4 + 3) * 264 + kl] = (bf16_t)(w1 >> 16);
    }
    __syncthreads();
#pragma unroll
    for (int i = 0; i < 2; ++i) {
        const int ch = tid + 512 * i, pr = ch >> 5, kc = (ch & 31) * 8;
        const u32x4 w = *(const LAS u32x4*)(lds + pr * 528 + kc * 2);
        *(u32x4*)(dst + (size_t)(p0 + pr) * K + k0 + kc) = w;
    }
    __syncthreads();
}
DI void sincos_d(double r, float& s, float& c) {
    const double r2 = r * r;
    double ts = 1.0, tc = 1.0, ss = 1.0, cs = 1.0;
#pragma unroll
    for (int n = 1; n <= 13; ++n) { tc = -tc * r2 * (1.0 / (double)((2 * n - 1) * (2 * n))); ts = -ts * r2 * (1.0 / (double)((2 * n) * (2 * n + 1))); cs += tc; ss += ts; }
    s = (float)(r * ss); c = (float)cs;
}
DI void p0_phase(LAS unsigned char* lds, const Params& p) {
    const int G = gridDim.x, bid = blockIdx.x, tid = opaque_tid();
    const size_t gtid = (size_t)bid * 512 + tid, gth = (size_t)G * 512;
    unsigned char* ws = p.ws;
    {
        const f32x4* xs = (const f32x4*)p.x; u32x4* xd = (u32x4*)(ws + WS_XB);
        constexpr size_t NV = (size_t)TOK * DM / 8;
        for (size_t i0 = gtid; i0 < NV; i0 += 4 * gth) {
            f32x4 a[4], b[4];
#pragma unroll
            for (int u = 0; u < 4; ++u) { const size_t i = i0 + u * gth; if (i < NV) { a[u] = __builtin_nontemporal_load(xs + 2 * i); b[u] = __builtin_nontemporal_load(xs + 2 * i + 1); } }
#pragma unroll
            for (int u = 0; u < 4; ++u) { const size_t i = i0 + u * gth; if (i < NV) { u32x4 w;
                w.x = pk_bf16(a[u][0], a[u][1]); w.y = pk_bf16(a[u][2], a[u][3]); w.z = pk_bf16(b[u][0], b[u][1]); w.w = pk_bf16(b[u][2], b[u][3]); xd[i] = w; } }
        }
    }
    {
        float* tabA = (float*)(ws + WS_TABA); float* tabB = (float*)(ws + WS_TABB);
        for (size_t idx = gtid; idx < (size_t)SEQ * 96; idx += gth) {
            const int pos = (int)(idx / 96), j = (int)(idx % 96);
            const bool dil = j >= 32; const int i = dil ? j - 32 : j;
            const float ex = dil ? (float)(2 * i) / 128.0f : (float)(2 * i) / 64.0f;
            const float inv = 1.0f / powf(10000.0f, ex);
            const float ang = (float)pos * inv;
            const double a = (double)ang; const double kk = rint(a * 0.15915494309189535);
            const double rr = a - kk * 6.283185307179586;
            float s, c; sincos_d(rr, s, c);
            float* d = dil ? tabB + ((size_t)pos * 64 + i) * 2 : tabA + ((size_t)pos * 32 + i) * 2;
            d[0] = c; d[1] = s;
        }
    }
    for (int t = bid; t < 6144; t += G) {
        const float* src; bf16_t* dst; int N, K, p0, c0, k0;
        if (t < 1024) {
            src = p.w_in; dst = (bf16_t*)(ws + WS_WQK); N = 6144; K = 2048; p0 = (t >> 3) * 32; k0 = (t & 7) * 256;
            const int pn = p0 >> 8, pp = p0 & 255, bj = pp >> 7, wc = (pp >> 5) & 3;
            const int lc = (pn >> 2) < 2 ? (64 * wc + 32 * bj) : (128 * (wc >> 1) + 64 * bj + 32 * (wc & 1));
            const int l = pn * 256 + lc; c0 = l < 2048 ? l : l + 1024;
        } else if (t < 1536) {
            const int tt = t - 1024; src = p.w_in; dst = (bf16_t*)(ws + WS_WV); N = 6144; K = 2048; p0 = (tt >> 3) * 32; k0 = (tt & 7) * 256;
            c0 = p0 < 1024 ? 2048 + p0 : 4096 + p0;
        } else if (t < 2048) {
            const int tt = t - 1536; src = p.w_out; dst = (bf16_t*)(ws + WS_WOUT); N = 2048; K = 2048; p0 = (tt >> 3) * 32; k0 = (tt & 7) * 256; c0 = p0;
        } else if (t < 4096) {
            const int tt = t - 2048; src = p.w_ff1; dst = (bf16_t*)(ws + WS_WFF1); N = 8192; K = 2048; p0 = (tt >> 3) * 32; k0 = (tt & 7) * 256; c0 = p0;
        } else {
            const int tt = t - 4096; src = p.w_ff2; dst = (bf16_t*)(ws + WS_WFF2); N = 2048; K = 8192; p0 = (tt >> 5) * 32; k0 = (tt & 31) * 256; c0 = p0;
        }
        tconv_tile(lds, src, N, K, dst, p0, c0, k0);
    }
}

constexpr int A_KP = 272, A_VP = 144, A_KB = 64 * A_KP, A_VB = 128 * A_VP, A_BUF = A_KB + A_VB, A_TBL = 2 * A_BUF, A_TBL_N = 2176;
constexpr float LOG2E = 1.4426950408889634f;

struct AItem { const bf16_t* Qb; const bf16_t* Kb; const bf16_t* VTb; bf16_t* Mb; int qb, type; };
DI void attn_preload(const AItem& it, bf16x8 (&qa)[4], bf16x8 (&qb4)[4], u32x4 (&kr)[2], u32x4 (&vr)[2]) {
    const int tid = opaque_tid(), lane = tid & 63, w = __builtin_amdgcn_readfirstlane(tid >> 6), r = lane & 31, h = lane >> 5;
    const bf16_t* qrow = it.Qb + (size_t)(it.qb * 256 + w * 32 + r) * 4096 + h * 8;
#pragma unroll
    for (int ks = 0; ks < 4; ++ks) { qa[ks] = *(const bf16x8*)(qrow + ks * 16); qb4[ks] = *(const bf16x8*)(qrow + 64 + ks * 16); }
    const int k_row0 = tid >> 4, k_c = tid & 15, v_row0 = tid >> 3, v_c = tid & 7;
#pragma unroll
    for (int i = 0; i < 2; ++i) {
        kr[i] = *(const u32x4*)(it.Kb + (size_t)(k_row0 + i * 32) * 4096 + k_c * 8);
        vr[i] = *(const u32x4*)(it.VTb + (size_t)(v_row0 + i * 64) * 32768 + v_c * 8);
    }
}
#define QF(i_) ((i_) < 4 ? qa[(i_) & 3] : qb4[(i_) & 3])
template <bool DIL>
DI void attn_item(LAS unsigned char* lds, const bf16_t* Qb, const bf16_t* Kb, const bf16_t* VTb, bf16_t* Mb, int qb, float lam, const float* subg,
                  bf16x8 (&qa)[4], bf16x8 (&qb4)[4], u32x4 (&kr)[2], u32x4 (&vr)[2], bool has_next, const AItem& nxt) {
    const int tid = opaque_tid(), lane = tid & 63, w = __builtin_amdgcn_readfirstlane(tid >> 6), r = lane & 31, h = lane >> 5;
    const int q0w = qb * 256 + w * 32;
    const int nt = 4 * qb + 4;
    const int k_row0 = tid >> 4, k_c = tid & 15, v_row0 = tid >> 3, v_c = tid & 7;
    const bf16_t* kg = Kb + (size_t)k_row0 * 4096 + k_c * 8;
    const bf16_t* vg = VTb + (size_t)v_row0 * 32768 + v_c * 8;
    const unsigned k_l = k_row0 * A_KP + k_c * 16, v_l = A_KB + v_row0 * A_VP + (v_c >> 1) * 32 + (v_c & 1) * 8;
    const unsigned ka_off = r * A_KP + h * 16, va_off = A_KB + r * A_VP + h * 16;
    constexpr int NPASS = DIL ? 1 : 2, NKS = DIL ? 8 : 4;
#pragma unroll
    for (int pass = 0; pass < NPASS; ++pass) {
        f32x16 oacc[4];
#pragma unroll
        for (int db = 0; db < 4; ++db)
#pragma unroll
            for (int i = 0; i < 16; ++i) oacc[db][i] = 0.f;
        float m_run = 0.f, l_run = 0.f;
#define A_LOAD(kt) do { _Pragma("unroll") for (int i_ = 0; i_ < 2; ++i_) { \
            kr[i_] = *(const u32x4*)(kg + (size_t)((kt) * 64 + i_ * 32) * 4096); \
            vr[i_] = *(const u32x4*)(vg + (size_t)(i_ * 64) * 32768 + (kt) * 64); } } while (0)
#define A_STORE(buf) do { LAS unsigned char* b_ = lds + (buf) * A_BUF; _Pragma("unroll") for (int i_ = 0; i_ < 2; ++i_) { \
            *(LAS u32x4*)(b_ + k_l + i_ * 32 * A_KP) = kr[i_]; \
            u32x2 lo_ = {vr[i_].x, vr[i_].y}, hi_ = {vr[i_].z, vr[i_].w}; \
            *(LAS u32x2*)(b_ + v_l + i_ * 64 * A_VP) = lo_; *(LAS u32x2*)(b_ + v_l + i_ * 64 * A_VP + 16) = hi_; } } while (0)
        A_STORE(0); __syncthreads();
        for (int kt = 0; kt < nt; ++kt) {
            const int cur = kt & 1;
            if (kt + 1 < nt) A_LOAD(kt + 1);
            if (kt * 64 <= q0w + 31) {
                LAS unsigned char* bp = lds + cur * A_BUF;
                f32x16 s0, s1;
                const float sinit = -m_run;
#pragma unroll
                for (int i = 0; i < 16; ++i) { s0[i] = sinit; s1[i] = sinit; }
                {
                    bf16x8 kf[2][4];
#define A_LDK(g_, d_) do { _Pragma("unroll") for (int q_ = 0; q_ < 4; ++q_) d_[q_] = *(const LAS bf16x8*)(bp + ka_off + (q_ & 1) * 32 * A_KP + pass * 128 + (2 * (g_) + (q_ >> 1)) * 32); } while (0)
                    A_LDK(0, kf[0]);
                    __builtin_amdgcn_s_setprio(1);
#pragma unroll
                    for (int g = 0; g < NKS / 2; ++g) {
                        if (g + 1 < NKS / 2) A_LDK(g + 1, kf[(g + 1) & 1]);
                        __builtin_amdgcn_sched_barrier(0);
                        s0 = MFMA32(kf[g & 1][0], QF(2 * g), s0); s1 = MFMA32(kf[g & 1][1], QF(2 * g), s1);
                        s0 = MFMA32(kf[g & 1][2], QF(2 * g + 1), s0); s1 = MFMA32(kf[g & 1][3], QF(2 * g + 1), s1);
                        __builtin_amdgcn_sched_barrier(0);
                    }
#undef A_LDK
                    __builtin_amdgcn_s_setprio(0);
                }
                const int base = q0w + r - 4 * h - kt * 64;
                float mx = -1e30f;
                if (DIL) {
                    const LAS float* tb = (const LAS float*)(lds + A_TBL) + (base + 65);
#pragma unroll
                    for (int kb = 0; kb < 2; ++kb)
#pragma unroll
                        for (int i = 0; i < 16; ++i) {
                            const float bias = tb[63 - (32 * kb + (i & 3) + 8 * (i >> 2))];
                            const float t = (kb ? s1[i] : s0[i]) + bias;
                            if (kb) s1[i] = t; else s0[i] = t;
                            mx = fmaxf(mx, t);
                        }
                } else if (kt * 64 + 63 > q0w) {
#pragma unroll
                    for (int kb = 0; kb < 2; ++kb)
#pragma unroll
                        for (int i = 0; i < 16; ++i) {
                            const int dlt = base - (32 * kb + (i & 3) + 8 * (i >> 2));
                            const float t = dlt >= 0 ? (kb ? s1[i] : s0[i]) : -1e30f;
                            if (kb) s1[i] = t; else s0[i] = t;
                            mx = fmaxf(mx, t);
                        }
                } else {
#pragma unroll
                    for (int i = 0; i < 16; ++i) mx = fmaxf(mx, fmaxf(s0[i], s1[i]));
                }
                mx = xhalf_max(mx);
                if (kt == 0 || __any(mx > 8.0f)) {
                    const float delta = kt == 0 ? mx : fmaxf(mx, 0.f);
                    m_run += delta;
                    if (kt != 0) {
                        const float alpha = __builtin_amdgcn_exp2f(-delta);
                        l_run *= alpha;
#pragma unroll
                        for (int db = 0; db < 4; ++db)
#pragma unroll
                            for (int i = 0; i < 16; ++i) oacc[db][i] *= alpha;
                    }
#pragma unroll
                    for (int i = 0; i < 16; ++i) { s0[i] -= delta; s1[i] -= delta; }
                }
                float ls = 0.f, ls2 = 0.f;
#pragma unroll
                for (int i = 0; i < 16; ++i) { const float p0 = __builtin_amdgcn_exp2f(s0[i]), p1 = __builtin_amdgcn_exp2f(s1[i]); s0[i] = p0; s1[i] = p1; ls += p0; asm volatile("" : "+v"(ls)); ls2 += p1; asm volatile("" : "+v"(ls2)); }
                l_run += ls + ls2;
                {
                    u32x4 pw[4];
#pragma unroll
                    for (int s = 0; s < 2; ++s) {
                        pw[s].x = pk_bf16(s0[8 * s + 0], s0[8 * s + 1]); pw[s].y = pk_bf16(s0[8 * s + 2], s0[8 * s + 3]); pw[s].z = pk_bf16(s0[8 * s + 4], s0[8 * s + 5]); pw[s].w = pk_bf16(s0[8 * s + 6], s0[8 * s + 7]);
                        pw[2 + s].x = pk_bf16(s1[8 * s + 0], s1[8 * s + 1]); pw[2 + s].y = pk_bf16(s1[8 * s + 2], s1[8 * s + 3]); pw[2 + s].z = pk_bf16(s1[8 * s + 4], s1[8 * s + 5]); pw[2 + s].w = pk_bf16(s1[8 * s + 6], s1[8 * s + 7]);
                    }
                    bf16x8 vf[2][4];
#define A_LDV(g_, d_) do { _Pragma("unroll") for (int db = 0; db < 4; ++db) { \
                        d_[db] = *(const LAS bf16x8*)(bp + va_off + db * 32 * A_VP + (g_) * 32); } } while (0)
                    A_LDV(0, vf[0]);
                    __builtin_amdgcn_s_setprio(1);
#pragma unroll
                    for (int g = 0; g < 4; ++g) {
                        if (g + 1 < 4) A_LDV(g + 1, vf[(g + 1) & 1]);
                        __builtin_amdgcn_sched_barrier(0);
                        const bf16x8 pb = __builtin_bit_cast(bf16x8, pw[g]);
#pragma unroll
                        for (int db = 0; db < 4; ++db) oacc[db] = MFMA32(vf[g & 1][db], pb, oacc[db]);
                        __builtin_amdgcn_sched_barrier(0);
                    }
#undef A_LDV
                    __builtin_amdgcn_s_setprio(0);
                }
            }
            if (kt + 1 < nt) A_STORE(cur ^ 1);
            __syncthreads();
        }
#undef A_LOAD
#undef A_STORE
        if (has_next) attn_preload(nxt, qa, qb4, kr, vr);
        const float l_tot = xhalf_sum(l_run);
        bf16_t* mp = Mb + (size_t)(q0w + r) * DM + 4 * h;
        if (DIL) {
            const float inv = 1.0f / l_tot;
#pragma unroll
            for (int db = 0; db < 4; ++db)
#pragma unroll
                for (int g = 0; g < 4; ++g) {
                    u32x2 wv; wv.x = pk_bf16(oacc[db][4 * g] * inv, oacc[db][4 * g + 1] * inv); wv.y = pk_bf16(oacc[db][4 * g + 2] * inv, oacc[db][4 * g + 3] * inv);
                    *(u32x2*)(mp + 32 * db + 8 * g) = wv;
                }
        } else if (pass == 0) {
            const float inv = 1.0f / l_tot;
#pragma unroll
            for (int db = 0; db < 4; ++db)
#pragma unroll
                for (int g = 0; g < 4; ++g) {
                    u32x2 wv; wv.x = pk_bf16(oacc[db][4 * g] * inv, oacc[db][4 * g + 1] * inv); wv.y = pk_bf16(oacc[db][4 * g + 2] * inv, oacc[db][4 * g + 3] * inv);
                    *(u32x2*)(mp + 32 * db + 8 * g) = wv;
                }
        } else {
            const float inv2 = lam / l_tot;
            float ss = 0.f;
#pragma unroll
            for (int db = 0; db < 4; ++db)
#pragma unroll
                for (int g = 0; g < 4; ++g) {
                    const u32x2 o1 = *(const volatile u32x2*)(mp + 32 * db + 8 * g);
                    const float a0 = bf_lo(o1.x) - oacc[db][4 * g] * inv2, a1 = bf_hi(o1.x) - oacc[db][4 * g + 1] * inv2;
                    const float a2 = bf_lo(o1.y) - oacc[db][4 * g + 2] * inv2, a3 = bf_hi(o1.y) - oacc[db][4 * g + 3] * inv2;
                    oacc[db][4 * g] = a0; oacc[db][4 * g + 1] = a1; oacc[db][4 * g + 2] = a2; oacc[db][4 * g + 3] = a3;
                    ss += a0 * a0 + a1 * a1 + a2 * a2 + a3 * a3;
                }
            ss = xhalf_sum(ss);
            const float rn = __builtin_amdgcn_rsqf(ss * (1.0f / 128.0f) + 1e-5f) * 0.8f;
#pragma unroll
            for (int db = 0; db < 4; ++db)
#pragma unroll
                for (int g = 0; g < 4; ++g) {
                    const f32x4 gv = *(const f32x4*)(subg + 32 * db + 8 * g + 4 * h);
                    u32x2 wv; wv.x = pk_bf16(oacc[db][4 * g] * rn * gv[0], oacc[db][4 * g + 1] * rn * gv[1]); wv.y = pk_bf16(oacc[db][4 * g + 2] * rn * gv[2], oacc[db][4 * g + 3] * rn * gv[3]);
                    *(u32x2*)(mp + 32 * db + 8 * g) = wv;
                }
        }
    }
}
DI void diff_scores(LAS unsigned char* bp, unsigned koff, const bf16x8 (&qf)[4], bool diag, bool first, int base, float& m_run, float& l_run, f32x16 (&oacc)[4], u32x4 (&pw)[4]) {
    f32x16 s0, s1;
    const float sinit = -m_run;
#pragma unroll
    for (int i = 0; i < 16; ++i) { s0[i] = sinit; s1[i] = sinit; }
    __builtin_amdgcn_s_setprio(1);
#pragma unroll
    for (int ks = 0; ks < 4; ++ks) {
        const bf16x8 a0 = *(const LAS bf16x8*)(bp + koff + ks * 32);
        const bf16x8 a1 = *(const LAS bf16x8*)(bp + koff + 32 * A_KP + ks * 32);
        s0 = MFMA32(a0, qf[ks], s0); s1 = MFMA32(a1, qf[ks], s1);
    }
    __builtin_amdgcn_s_setprio(0);
    float mx = -1e30f;
    if (diag) {
#pragma unroll
        for (int kb = 0; kb < 2; ++kb)
#pragma unroll
            for (int i = 0; i < 16; ++i) {
                const int dlt = base - (32 * kb + (i & 3) + 8 * (i >> 2));
                const float t = dlt >= 0 ? (kb ? s1[i] : s0[i]) : -1e30f;
                if (kb) s1[i] = t; else s0[i] = t;
                mx = fmaxf(mx, t);
            }
    } else {
#pragma unroll
        for (int i = 0; i < 16; ++i) mx = fmaxf(mx, fmaxf(s0[i], s1[i]));
    }
    mx = xhalf_max(mx);
    if (first || __any(mx > 8.0f)) {
        const float delta = first ? mx : fmaxf(mx, 0.f);
        m_run += delta;
        if (!first) {
            const float alpha = __builtin_amdgcn_exp2f(-delta);
            l_run *= alpha;
#pragma unroll
            for (int db = 0; db < 4; ++db)
#pragma unroll
                for (int i = 0; i < 16; ++i) oacc[db][i] *= alpha;
        }
#pragma unroll
        for (int i = 0; i < 16; ++i) { s0[i] -= delta; s1[i] -= delta; }
    }
    float ls = 0.f, ls2 = 0.f;
#pragma unroll
    for (int i = 0; i < 16; ++i) { const float p0 = __builtin_amdgcn_exp2f(s0[i]), p1 = __builtin_amdgcn_exp2f(s1[i]); s0[i] = p0; s1[i] = p1; ls += p0; asm volatile("" : "+v"(ls)); ls2 += p1; asm volatile("" : "+v"(ls2)); }
    l_run += ls + ls2;
#pragma unroll
    for (int s = 0; s < 2; ++s) {
        pw[s].x = pk_bf16(s0[8 * s + 0], s0[8 * s + 1]); pw[s].y = pk_bf16(s0[8 * s + 2], s0[8 * s + 3]); pw[s].z = pk_bf16(s0[8 * s + 4], s0[8 * s + 5]); pw[s].w = pk_bf16(s0[8 * s + 6], s0[8 * s + 7]);
        pw[2 + s].x = pk_bf16(s1[8 * s + 0], s1[8 * s + 1]); pw[2 + s].y = pk_bf16(s1[8 * s + 2], s1[8 * s + 3]); pw[2 + s].z = pk_bf16(s1[8 * s + 4], s1[8 * s + 5]); pw[2 + s].w = pk_bf16(s1[8 * s + 6], s1[8 * s + 7]);
    }
}
DI void attn_item_diff(LAS unsigned char* lds, const bf16_t* Qb, const bf16_t* Kb, const bf16_t* VTb, bf16_t* Mb, int qb, float lam, const float* subg,
                       bf16x8 (&qa)[4], bf16x8 (&qb4)[4], u32x4 (&kr)[2], u32x4 (&vr)[2], bool has_next, const AItem& nxt) {
    const int tid = opaque_tid(), lane = tid & 63, w = __builtin_amdgcn_readfirstlane(tid >> 6), r = lane & 31, h = lane >> 5;
    const int q0w = qb * 256 + w * 32;
    const int nt = 4 * qb + 4;
    const int k_row0 = tid >> 4, k_c = tid & 15, v_row0 = tid >> 3, v_c = tid & 7;
    const bf16_t* kg = Kb + (size_t)k_row0 * 4096 + k_c * 8;
    const bf16_t* vg = VTb + (size_t)v_row0 * 32768 + v_c * 8;
    const unsigned k_l = k_row0 * A_KP + k_c * 16, v_l = A_KB + v_row0 * A_VP + (v_c >> 1) * 32 + (v_c & 1) * 8;
    const unsigned ka_off = r * A_KP + h * 16, va_off = A_KB + r * A_VP + h * 16;
    f32x16 oa[4], ob[4];
#pragma unroll
    for (int db = 0; db < 4; ++db)
#pragma unroll
        for (int i = 0; i < 16; ++i) { oa[db][i] = 0.f; ob[db][i] = 0.f; }
    float m1 = 0.f, m2 = 0.f, l1 = 0.f, l2 = 0.f;
#define D_LOAD(kt) do { _Pragma("unroll") for (int i_ = 0; i_ < 2; ++i_) { \
        kr[i_] = *(const u32x4*)(kg + (size_t)((kt) * 64 + i_ * 32) * 4096); \
        vr[i_] = *(const u32x4*)(vg + (size_t)(i_ * 64) * 32768 + (kt) * 64); } } while (0)
#define D_STORE(buf) do { LAS unsigned char* b_ = lds + (buf) * A_BUF; _Pragma("unroll") for (int i_ = 0; i_ < 2; ++i_) { \
        *(LAS u32x4*)(b_ + k_l + i_ * 32 * A_KP) = kr[i_]; \
        u32x2 lo_ = {vr[i_].x, vr[i_].y}, hi_ = {vr[i_].z, vr[i_].w}; \
        *(LAS u32x2*)(b_ + v_l + i_ * 64 * A_VP) = lo_; *(LAS u32x2*)(b_ + v_l + i_ * 64 * A_VP + 16) = hi_; } } while (0)
    D_STORE(0); __syncthreads();
    for (int kt = 0; kt < nt; ++kt) {
        const int cur = kt & 1;
        if (kt + 1 < nt) D_LOAD(kt + 1);
        if (kt * 64 <= q0w + 31) {
            LAS unsigned char* bp = lds + cur * A_BUF;
            const bool diag = kt * 64 + 63 > q0w;
            const int base = q0w + r - 4 * h - kt * 64;
            u32x4 pw[4];
#define D_PV(acc_) do { __builtin_amdgcn_s_setprio(1); _Pragma("unroll") for (int g = 0; g < 4; ++g) { \
                const bf16x8 pb_ = __builtin_bit_cast(bf16x8, pw[g]); \
                _Pragma("unroll") for (int db = 0; db < 4; ++db) { \
                    const bf16x8 va_ = *(const LAS bf16x8*)(bp + va_off + db * 32 * A_VP + g * 32); \
                    acc_[db] = MFMA32(va_, pb_, acc_[db]); } } \
                __builtin_amdgcn_s_setprio(0); } while (0)
            diff_scores(bp, ka_off, qa, diag, kt == 0, base, m1, l1, oa, pw);
            D_PV(oa);
            diff_scores(bp, ka_off + 128, qb4, diag, kt == 0, base, m2, l2, ob, pw);
            D_PV(ob);
#undef D_PV
        }
        if (kt + 1 < nt) D_STORE(cur ^ 1);
        __syncthreads();
    }
#undef D_LOAD
#undef D_STORE
    if (has_next) attn_preload(nxt, qa, qb4, kr, vr);
    const float inv1 = 1.0f / xhalf_sum(l1), inv2 = lam / xhalf_sum(l2);
    bf16_t* mp = Mb + (size_t)(q0w + r) * DM + 4 * h;
    float ss = 0.f;
#pragma unroll
    for (int db = 0; db < 4; ++db)
#pragma unroll
        for (int i = 0; i < 16; ++i) { const float a = oa[db][i] * inv1 - ob[db][i] * inv2; oa[db][i] = a; ss += a * a; }
    ss = xhalf_sum(ss);
    const float rn = __builtin_amdgcn_rsqf(ss * (1.0f / 128.0f) + 1e-5f) * 0.8f;
#pragma unroll
    for (int db = 0; db < 4; ++db)
#pragma unroll
        for (int g = 0; g < 4; ++g) {
            const f32x4 gv = *(const f32x4*)(subg + 32 * db + 8 * g + 4 * h);
            u32x2 wv; wv.x = pk_bf16(oa[db][4 * g] * rn * gv[0], oa[db][4 * g + 1] * rn * gv[1]); wv.y = pk_bf16(oa[db][4 * g + 2] * rn * gv[2], oa[db][4 * g + 3] * rn * gv[3]);
            *(u32x2*)(mp + 32 * db + 8 * g) = wv;
        }
}
DI void attn_phase(LAS unsigned char* lds, const Params& p) {
    float d1 = 0.f, d2 = 0.f;
    for (int i = 0; i < 64; ++i) { d1 += p.lq1[i] * p.lk1[i]; d2 += p.lq2[i] * p.lk2[i]; }
    const float lam = __expf(d1) - __expf(d2) + 0.2f;
    const bf16_t* QK = (const bf16_t*)(p.ws + WS_QK); const bf16_t* VT = (const bf16_t*)(p.ws + WS_VT); bf16_t* MIX = (bf16_t*)(p.ws + WS_XB);
    {
        LAS float* tb = (LAS float*)(lds + A_TBL);
        for (int idx = opaque_tid(); idx < A_TBL_N; idx += 512) {
            const int dlt = idx - 128;
            const int cnt = (dlt <= 128 ? 1 : 0) + ((((dlt & 3) == 0) && dlt <= 512) ? 1 : 0) + (((dlt & 15) == 0) ? 1 : 0);
            tb[idx] = (dlt < 0 || cnt == 0) ? -1e30f : (cnt == 3 ? 1.5849625007211562f : (cnt == 2 ? 1.0f : 0.0f));
        }
        __syncthreads();
    }
    const int nit = blockIdx.x < 1024 ? 2 * ((1024 - (int)blockIdx.x + (int)gridDim.x - 1) / (int)gridDim.x) : 0;
    auto desc = [&](int j) {
        const int idx = blockIdx.x + (j >> 1) * gridDim.x;
        const int rr = idx >> 8, v = idx & 255, x = v & 7, s = v >> 3, gq = s >> 2, mm = s & 3;
        const int combo = rr * 64 + x * 8 + gq;
        const int type = combo >> 7, b = (combo >> 3) & 15, hh = combo & 7;
        AItem it;
        it.Qb = QK + (size_t)b * SEQ * 4096 + type * 2048 + hh * 128; it.Kb = it.Qb + 1024;
        it.VTb = VT + (size_t)(type * 1024 + hh * 128) * TOK + b * SEQ;
        it.Mb = MIX + (size_t)b * SEQ * DM + type * 1024 + hh * 128;
        it.qb = (j & 1) ? mm : 7 - mm; it.type = type;
        return it;
    };
    bf16x8 qa[4], qb4[4]; u32x4 kr[2], vr[2];
    if (nit > 0) { const AItem it0 = desc(0); attn_preload(it0, qa, qb4, kr, vr); }
#pragma unroll 1
    for (int j = 0; j < nit; ++j) {
        const AItem it = desc(j);
        const bool hn = j + 1 < nit;
        const AItem nx = desc(hn ? j + 1 : j);
        if (it.type) attn_item<true>(lds, it.Qb, it.Kb, it.VTb, it.Mb, it.qb, lam, p.subg, qa, qb4, kr, vr, hn, nx);
        else attn_item_diff(lds, it.Qb, it.Kb, it.VTb, it.Mb, it.qb, lam, p.subg, qa, qb4, kr, vr, hn, nx);
    }
}

DI float wave_sum(float v) {
#pragma unroll
    for (int o = 32; o >= 1; o >>= 1) v += __shfl_xor(v, o);
    return v;
}
DI void ln_phase(const bf16_t* in, float* of, bf16_t* ob, float* stats, const float* g, const float* b) {
    const int tid = opaque_tid(); const int lane = tid & 63, gw = blockIdx.x * 8 + (tid >> 6), nw = gridDim.x * 8;
    u32x4 nx[4];
    if (gw < TOK) {
#pragma unroll
        for (int i = 0; i < 4; ++i) nx[i] = *(const u32x4*)(in + (size_t)gw * DM + i * 512 + lane * 8);
    }
    for (int row = gw; row < TOK; row += nw) {
        float v[32]; float s = 0.f;
#pragma unroll
        for (int i = 0; i < 4; ++i)
#pragma unroll
            for (int j = 0; j < 4; ++j) { v[8 * i + 2 * j] = bf_lo(nx[i][j]); v[8 * i + 2 * j + 1] = bf_hi(nx[i][j]); s += v[8 * i + 2 * j] + v[8 * i + 2 * j + 1]; }
        if (row + nw < TOK) {
#pragma unroll
            for (int i = 0; i < 4; ++i) nx[i] = *(const u32x4*)(in + (size_t)(row + nw) * DM + i * 512 + lane * 8);
        }
        const float mean = wave_sum(s) * (1.0f / DM);
        float q = 0.f;
#pragma unroll
        for (int e = 0; e < 32; ++e) { const float d = v[e] - mean; q += d * d; }
        const float rstd = 1.0f / sqrtf(wave_sum(q) * (1.0f / DM) + 1e-5f);
        if (stats && lane == 0) { f32x2 st = {mean, rstd}; *(f32x2*)(stats + 2 * row) = st; }
#pragma unroll
        for (int i = 0; i < 4; ++i) {
            const int c = i * 512 + lane * 8;
            const f32x4 g0 = *(const f32x4*)(g + c), g1 = *(const f32x4*)(g + c + 4), b0 = *(const f32x4*)(b + c), b1 = *(const f32x4*)(b + c + 4);
            f32x4 y0, y1;
#pragma unroll
            for (int j = 0; j < 4; ++j) { y0[j] = (v[8 * i + j] - mean) * rstd * g0[j] + b0[j]; y1[j] = (v[8 * i + 4 + j] - mean) * rstd * g1[j] + b1[j]; }
            if (of) { *(f32x4*)(of + (size_t)row * DM + c) = y0; *(f32x4*)(of + (size_t)row * DM + c + 4) = y1; }
            if (ob) { u32x4 wv; wv.x = pk_bf16(y0[0], y0[1]); wv.y = pk_bf16(y0[2], y0[3]); wv.z = pk_bf16(y1[0], y1[1]); wv.w = pk_bf16(y1[2], y1[3]); *(u32x4*)(ob + (size_t)row * DM + c) = wv; }
        }
    }
}

typedef const __attribute__((address_space(4))) Params* KParamsPtr;
DI Params load_params() {
#if defined(__HIP_DEVICE_COMPILE__)
    unsigned long long a = (unsigned long long)__builtin_amdgcn_kernarg_segment_ptr();
    asm volatile("" : "+s"(a));
    KParamsPtr kp = (KParamsPtr)a;
    Params r;
    r.x = kp->x; r.w_in = kp->w_in; r.lq1 = kp->lq1; r.lk1 = kp->lk1; r.lq2 = kp->lq2; r.lk2 = kp->lk2; r.subg = kp->subg; r.w_out = kp->w_out;
    r.ln1g = kp->ln1g; r.ln1b = kp->ln1b; r.w_ff1 = kp->w_ff1; r.w_ff2 = kp->w_ff2; r.ln2g = kp->ln2g; r.ln2b = kp->ln2b; r.out = kp->out; r.ws = kp->ws;
    return r;
#else
    return Params{};
#endif
}
#define PHASE_PARAMS() const Params p = load_params(); unsigned char* ws = p.ws; \
    bf16_t* XB = (bf16_t*)(ws + WS_XB); bf16_t* QK = (bf16_t*)(ws + WS_QK); bf16_t* VT = (bf16_t*)(ws + WS_VT); bf16_t* X1B = (bf16_t*)(ws + WS_X1B); bf16_t* HDN = (bf16_t*)(ws + WS_HDN); \
    (void)XB; (void)QK; (void)VT; (void)X1B; (void)HDN
__global__ void __launch_bounds__(512, 2) fwd_megakernel(Params p_in) {
    extern __shared__ __attribute__((aligned(16))) unsigned char lds_raw[];
    LAS unsigned char* lds = (LAS unsigned char*)lds_raw;
    cg::grid_group grid = cg::this_grid();
    __shared__ __attribute__((aligned(16))) unsigned xb_st[4];
    if (threadIdx.x < 4) xb_st[threadIdx.x] = 0u;
    __syncthreads();
    const XcdBarrier xbar = xcd_barrier_post((unsigned*)(p_in.ws + WS_BAR), (volatile LAS unsigned*)xb_st);
    const int G = gridDim.x, bid = blockIdx.x;

    { PHASE_PARAMS(); p0_phase(lds, p); __syncthreads(); }
    grid.sync();
    {
        PHASE_PARAMS();
        pg8::Gemm g{XB, (const bf16_t*)(ws + WS_WQK), TOK, 4096, DM}; pg8::StaticOrder S; S.init(TOK, 4096, G, bid);
        EpiRope E{QK, (const float*)(ws + WS_TABA), (const float*)(ws + WS_TABB)};
        pg8::gemm_phase<EpiRope, pg8::StaticOrder>(lds, g, S, E, nullptr);
    }
    {
        PHASE_PARAMS();
        pg8::Gemm g{(const bf16_t*)(ws + WS_WV), XB, 2048, TOK, DM}; pg8::StaticOrder S; S.init(2048, TOK, G, bid);
        EpiBf<0> E{VT, TOK};
        pg8::gemm_phase<EpiBf<0>, pg8::StaticOrder>(lds, g, S, E, nullptr);
    }
    xcd_barrier(xbar);
    { PHASE_PARAMS(); attn_phase(lds, p); }
    xcd_barrier(xbar);
    {
        PHASE_PARAMS();
        pg8::Gemm g{XB, (const bf16_t*)(ws + WS_WOUT), TOK, DM, DM}; pg8::StaticOrder S; S.init(TOK, DM, G, bid);
        EpiResBf E{p.x, (bf16_t*)p.out};
        pg8::gemm_phase<EpiResBf, pg8::StaticOrder>(lds, g, S, E, nullptr);
    }
    xcd_barrier(xbar);
    { PHASE_PARAMS(); ln_phase((const bf16_t*)p.out, nullptr, X1B, (float*)(ws + WS_STATS), p.ln1g, p.ln1b); }
    xcd_barrier(xbar);
    {
        PHASE_PARAMS();
        pg8::Gemm g{X1B, (const bf16_t*)(ws + WS_WFF1), TOK, DFF, DM}; pg8::StaticOrder S; S.init(TOK, DFF, G, bid);
        EpiBf<1> E{HDN, DFF};
        pg8::gemm_phase<EpiBf<1>, pg8::StaticOrder>(lds, g, S, E, nullptr);
    }
    xcd_barrier(xbar);
    {
        PHASE_PARAMS();
        pg8::Gemm g{HDN, (const bf16_t*)(ws + WS_WFF2), TOK, DM, DFF}; pg8::StaticOrder S; S.init(TOK, DM, G, bid);
        EpiResLnBf E{(const bf16_t*)p.out, (const float*)(ws + WS_STATS), p.ln1g, p.ln1b, X1B};
        pg8::gemm_phase<EpiResLnBf, pg8::StaticOrder>(lds, g, S, E, nullptr);
    }
    xcd_barrier(xbar);
    { PHASE_PARAMS(); ln_phase(X1B, p.out, nullptr, nullptr, p.ln2g, p.ln2b); }
}

extern "C" void kernel_launch(void* const* d_in, const int* in_sizes, int n_in, void* d_out, int out_size, void* d_ws, size_t ws_size, hipStream_t stream) {
    static int grid = 0;
    if (grid == 0) {
        if (n_in != 14 || in_sizes[0] != TOK * DM || out_size != TOK * DM || ws_size < WS_END) {
            fprintf(stderr, "kernel_launch: unexpected shapes (n_in %d, in0 %d, out %d, ws %zu)\n", n_in, n_in > 0 ? in_sizes[0] : -1, out_size, ws_size); grid = -1; return; }
        int dev = 0, cus = 0, per_cu = 0;
        (void)hipGetDevice(&dev); (void)hipDeviceGetAttribute(&cus, hipDeviceAttributeMultiprocessorCount, dev);
        if (hipFuncSetAttribute((const void*)fwd_megakernel, hipFuncAttributeMaxDynamicSharedMemorySize, LDS_BYTES) != hipSuccess) { fprintf(stderr, "kernel_launch: hipFuncSetAttribute failed\n"); grid = -1; return; }
        if (hipOccupancyMaxActiveBlocksPerMultiprocessor(&per_cu, (const void*)fwd_megakernel, 512, LDS_BYTES) != hipSuccess || per_cu < 1) { fprintf(stderr, "kernel_launch: occupancy query gave %d\n", per_cu); per_cu = 1; }
        (void)hipGetLastError();
        grid = cus * per_cu;
    }
    if (grid < 0) return;
    Params p{};
    p.x = (const float*)d_in[0]; p.w_in = (const float*)d_in[1]; p.lq1 = (const float*)d_in[2]; p.lk1 = (const float*)d_in[3]; p.lq2 = (const float*)d_in[4]; p.lk2 = (const float*)d_in[5];
    p.subg = (const float*)d_in[6]; p.w_out = (const float*)d_in[7]; p.ln1g = (const float*)d_in[8]; p.ln1b = (const float*)d_in[9]; p.w_ff1 = (const float*)d_in[10]; p.w_ff2 = (const float*)d_in[11];
    p.ln2g = (const float*)d_in[12]; p.ln2b = (const float*)d_in[13]; p.out = (float*)d_out; p.ws = (unsigned char*)d_ws;
    if (hipMemsetAsync((unsigned char*)d_ws + WS_BAR, 0, XCD_BAR_WORDS * sizeof(unsigned), stream) != hipSuccess) { fprintf(stderr, "kernel_launch: hipMemsetAsync of the barrier words failed\n"); return; }
    void* args[] = {&p};
    hipError_t e = hipLaunchCooperativeKernel((const void*)fwd_megakernel, dim3(grid), dim3(512), args, LDS_BYTES, stream);
    if (e != hipSuccess) fprintf(stderr, "kernel_launch: cooperative launch failed: %s (grid %d)\n", hipGetErrorString(e), grid);
}
```

```cpp
#include <hip/hip_runtime.h>
#include <hip/hip_cooperative_groups.h>
#include <cstdio>
namespace cg = cooperative_groups;
namespace pg8 {
#define PG8_LAS __attribute__((address_space(3)))
typedef unsigned short bf16_t;
typedef short bf16x8 __attribute__((ext_vector_type(8)));
typedef float f32x4 __attribute__((ext_vector_type(4)));
typedef unsigned u32x4 __attribute__((ext_vector_type(4)));
constexpr int BM = 256, BK = 64, HALF = 128, HTB = HALF * BK * 2  , STAGE_BYTES = 8 * HTB, NXCD = 8, WGM = 8;

__host__ __device__ __forceinline__ int lds_byte(int r, int c) { const int st = (r >> 4) * 2 + (c >> 5), rr = r & 15, cc = c & 31, ob = rr * 64 + cc * 2; return st * 1024 + (ob ^ (((ob >> 9) & 1) << 5)); }
__host__ __device__ __forceinline__ void stage_rc(int b, int& R, int& C) { const int st = b / 1024, sb = b % 1024, swz = sb ^ (((sb >> 9) & 1) << 5); R = (st >> 1) * 16 + swz / 64; C = (st & 1) * 32 + (swz % 64) / 2; }
__host__ __device__ __forceinline__ int perm32(int rho) { const int n = rho >> 4, i = rho & 15; return 8 * (i >> 2) + 4 * n + (i & 3); }

struct Unit { int pm, pn; };
struct Gemm { const bf16_t* A; const bf16_t* Bt; int M, N, K; };

struct StaticOrder {
    int nM, nN, nwg, G, c;
    __host__ __device__ void init(int M, int N, int G_, int c_) { nM = M / BM; nN = N / BM; nwg = nM * nN; G = G_; c = c_; }
    __host__ __device__ bool next(int i, Unit& u) const {
        const long L = (long)i * G + c; if (L >= nwg) return false;
        int wgid = (int)L; { const int q = nwg / NXCD, r = nwg % NXCD, xcd = wgid % NXCD, off = wgid / NXCD; wgid = (xcd < r ? xcd * (q + 1) : r * (q + 1) + (xcd - r) * q) + off; }
        const int nig = WGM * nN, gid = wgid / nig, fm = gid * WGM, gsz = (nM - fm) < WGM ? (nM - fm) : WGM;
        u.pm = fm + ((wgid % nig) % gsz); u.pn = (wgid % nig) / gsz; return true;
    }
    __device__ __forceinline__ void a_ready(const Unit&) const {}
    __device__ __forceinline__ void done(const Unit&) const {}
};

typedef int v8i_t __attribute__((ext_vector_type(8)));
typedef int v4i_t __attribute__((ext_vector_type(4)));
__device__ __forceinline__ v8i_t cat8(bf16x8 a, bf16x8 b) { return __builtin_shufflevector(__builtin_bit_cast(v4i_t, a), __builtin_bit_cast(v4i_t, b), 0, 1, 2, 3, 4, 5, 6, 7); }
template <class Epi, class Sched, bool FP8 = false, bool STAMP = false>
__device__ __forceinline__ void gemm_phase(PG8_LAS unsigned char* lds, const Gemm g, const Sched& S, const Epi& E, unsigned long long* stamps) {
    int tid_ = threadIdx.x; asm volatile("" : "+v"(tid_)); const int tid = tid_, wid = __builtin_amdgcn_readfirstlane(tid >> 6), lane = tid & 63, wr = wid >> 2, wc = wid & 3, fr = lane & 15, fq = lane >> 4;
    const int K = g.K, nt = K / BK;
    int ts_lo = 0, ts_hi = 0, nts = 0; const unsigned long long rt_entry = STAMP ? (unsigned long long)wall_clock64() : 0ull;
#define PG8_STAMP() do { if (STAMP && wid == 0 && nts < 64) { const unsigned long long _c = (unsigned long long)clock64(); \
        ts_lo = (lane == nts) ? (int)(unsigned)_c : ts_lo; ts_hi = (lane == nts) ? (int)(unsigned)(_c >> 32) : ts_hi; ++nts; } } while (0)
    PG8_STAMP();
    unsigned voffA[2], voffB[2];
#pragma unroll
    for (int i = 0; i < 2; ++i) { int R, C; stage_rc(tid * 16 + i * 8192, R, C); const int Rb = Epi::PERM ? ((R & ~31) + perm32(R & 31)) : R;
        voffA[i] = (unsigned)(R * K + C) * 2u; voffB[i] = (unsigned)(Rb * K + C) * 2u; }
    const size_t kstep = (size_t)(BK * 2);
    const size_t hstep = (size_t)HALF * K * 2;
    const size_t tstep = 2 * hstep;
    const unsigned ldsw = (unsigned)wid * 1024u;
    const int aoff = lds_byte(wr * 64 + fr, fq * 8), boff = lds_byte(wc * 32 + fr, fq * 8);
#define PG8_SA(b, h) (((b) * 2 + (h)) * HTB)
#define PG8_SB(b, h) ((4 + (b) * 2 + (h)) * HTB)
#define PG8_STAGE(bufoff, gbase, voff) do { _Pragma("unroll") for (int _i = 0; _i < 2; ++_i) \
        __builtin_amdgcn_global_load_lds((const unsigned*)((const char*)(gbase) + (voff)[_i]), (PG8_LAS unsigned*)(lds + (bufoff) + ldsw + _i * 8192), 16, 0, 0); } while (0)
#define PG8_LDA(dst, b, h) do { _Pragma("unroll") for (int m = 0; m < 4; ++m) _Pragma("unroll") for (int k = 0; k < 2; ++k) dst[m][k] = *(const PG8_LAS bf16x8*)(lds + PG8_SA(b, h) + aoff + m * 2048 + k * 1024); } while (0)
#define PG8_LDB(dst, b, h) do { _Pragma("unroll") for (int n = 0; n < 2; ++n) _Pragma("unroll") for (int k = 0; k < 2; ++k) dst[n][k] = *(const PG8_LAS bf16x8*)(lds + PG8_SB(b, h) + boff + n * 2048 + k * 1024); } while (0)
#define PG8_MMA(ai, bj, At, Bt) do { __builtin_amdgcn_s_setprio(1); _Pragma("unroll") for (int m = 0; m < 4; ++m) _Pragma("unroll") for (int n = 0; n < 2; ++n) { \
        if constexpr (FP8) { asm volatile("v_mfma_scale_f32_16x16x128_f8f6f4 %0, %1, %2, %0, %3, %3 op_sel_hi:[0,0,0]" : "+v"(acc[ai][bj][m][n]) : "v"(cat8(Bt[n][0], Bt[n][1])), "v"(cat8(At[m][0], At[m][1])), "v"(f8scale)); } \
        else { _Pragma("unroll") for (int k = 0; k < 2; ++k) acc[ai][bj][m][n] = __builtin_amdgcn_mfma_f32_16x16x32_bf16(Bt[n][k], At[m][k], acc[ai][bj][m][n], 0, 0, 0); } } \
        __builtin_amdgcn_s_setprio(0); } while (0)
#define PG8_WAIT_V(n) asm volatile("s_waitcnt vmcnt(" #n ")" ::: "memory")
#define PG8_WAIT_L(n) asm volatile("s_waitcnt lgkmcnt(" #n ")" ::: "memory")
#define PG8_BAR __builtin_amdgcn_s_barrier()
#define PG8_SCHED __builtin_amdgcn_sched_barrier(0)
    Unit cur, nxt; int ui = 0;
    if (!S.next(0, cur)) return;
    f32x4 acc[2][2][4][2];
#pragma unroll
    for (int a = 0; a < 2; ++a)
#pragma unroll
        for (int b = 0; b < 2; ++b)
#pragma unroll
            for (int m = 0; m < 4; ++m)
#pragma unroll
                for (int n = 0; n < 2; ++n) acc[a][b][m][n] = (f32x4){0.f, 0.f, 0.f, 0.f};
    bf16x8 At[4][2], B0[2][2], B1[2][2];
    const int f8scale = 0x7f7f7f7f;
    const char* cA = (const char*)g.A + (size_t)cur.pm * tstep; const char* cB = (const char*)g.Bt + (size_t)cur.pn * tstep;
    S.a_ready(cur);
    PG8_STAGE(PG8_SB(0, 0), cB, voffB); PG8_STAGE(PG8_SA(0, 0), cA, voffA); PG8_STAGE(PG8_SB(0, 1), cB + hstep, voffB); PG8_STAGE(PG8_SA(0, 1), cA + hstep, voffA);
    if (wr == 1) PG8_BAR;
    PG8_WAIT_V(4); PG8_BAR;
    PG8_STAGE(PG8_SB(1, 0), cB + kstep, voffB); PG8_STAGE(PG8_SA(1, 0), cA + kstep, voffA); PG8_STAGE(PG8_SB(1, 1), cB + hstep + kstep, voffB);
    PG8_WAIT_V(6); PG8_BAR;
    PG8_STAMP();
    for (;;) {
        const bool has_next = S.next(ui + 1, nxt);
        const char* nA = has_next ? (const char*)g.A + (size_t)nxt.pm * tstep : cA; const char* nB = has_next ? (const char*)g.Bt + (size_t)nxt.pn * tstep : cB;
        for (int t = 0; t < nt; t += 2) {
            const bool last = (t == nt - 2);
            const char* a1 = cA + (size_t)(t + 1) * kstep;
            const char* a2 = last ? nA : cA + (size_t)(t + 2) * kstep; const char* b2 = last ? nB : cB + (size_t)(t + 2) * kstep;
            const char* a3 = a2 + kstep; const char* b3 = b2 + kstep;
            if (last && has_next) S.a_ready(nxt);
            PG8_LDB(B0, 0, 0); PG8_SCHED; PG8_LDA(At, 0, 0); PG8_STAGE(PG8_SA(1, 1), a1 + hstep, voffA);
            PG8_WAIT_L(8); PG8_BAR; PG8_WAIT_L(0); PG8_MMA(0, 0, At, B0); PG8_BAR; PG8_SCHED;
            PG8_LDB(B1, 0, 1); PG8_STAGE(PG8_SB(0, 0), b2, voffB);
            PG8_BAR; PG8_WAIT_L(0); PG8_MMA(0, 1, At, B1); PG8_BAR;
            PG8_LDA(At, 0, 1); PG8_STAGE(PG8_SA(0, 0), a2, voffA);
            PG8_BAR; PG8_WAIT_L(0); PG8_MMA(1, 0, At, B0); PG8_BAR; PG8_SCHED;
            PG8_STAGE(PG8_SB(0, 1), b2 + hstep, voffB);
            PG8_WAIT_V(6); PG8_BAR; PG8_MMA(1, 1, At, B1); PG8_BAR;
            PG8_LDB(B0, 1, 0); PG8_SCHED; PG8_LDA(At, 1, 0); PG8_STAGE(PG8_SA(0, 1), a2 + hstep, voffA);
            PG8_WAIT_L(8); PG8_BAR; PG8_WAIT_L(0); PG8_MMA(0, 0, At, B0); PG8_BAR; PG8_SCHED;
            PG8_LDB(B1, 1, 1); PG8_STAGE(PG8_SB(1, 0), b3, voffB);
            PG8_BAR; PG8_WAIT_L(0); PG8_MMA(0, 1, At, B1); PG8_BAR;
            PG8_LDA(At, 1, 1); PG8_STAGE(PG8_SA(1, 0), a3, voffA);
            PG8_BAR; PG8_WAIT_L(0); PG8_MMA(1, 0, At, B0); PG8_BAR; PG8_SCHED;
            PG8_STAGE(PG8_SB(1, 1), b3 + hstep, voffB);
            PG8_WAIT_V(6); PG8_BAR; PG8_MMA(1, 1, At, B1); PG8_BAR;
        }
        PG8_STAMP();
        if constexpr (FP8) { asm volatile("s_nop 15\n\ts_nop 15" ::: "memory"); }
        if constexpr (!Epi::AFTER_DRAIN) { E(acc, cur, wr, wc, fr, fq); S.done(cur); }
        PG8_STAMP();
        if (!has_next) break;
#pragma unroll
        for (int a = 0; a < 2; ++a)
#pragma unroll
            for (int b = 0; b < 2; ++b)
#pragma unroll
                for (int m = 0; m < 4; ++m)
#pragma unroll
                    for (int n = 0; n < 2; ++n) acc[a][b][m][n] = (f32x4){0.f, 0.f, 0.f, 0.f};
        cur = nxt; cA = nA; cB = nB; ++ui;
    }
    PG8_WAIT_V(0);
    if (wr == 0) PG8_BAR;
    PG8_BAR;
    if constexpr (Epi::AFTER_DRAIN) { E.fused(acc, cur, wr, wc, fr, fq, lds, wid, lane); S.done(cur); }
    PG8_STAMP();
    if (STAMP && wid == 0) { stamps[lane] = lane < nts ? (((unsigned long long)(unsigned)ts_hi << 32) | (unsigned)ts_lo) : 0ull;
        if (lane == 62) stamps[62] = rt_entry; if (lane == 63) stamps[63] = (unsigned long long)wall_clock64(); }
#undef PG8_STAMP
#undef PG8_SA
#undef PG8_SB
#undef PG8_STAGE
#undef PG8_LDA
#undef PG8_LDB
#undef PG8_MMA
#undef PG8_WAIT_V
#undef PG8_WAIT_L
#undef PG8_BAR
#undef PG8_SCHED
}
}
#define LAS __attribute__((address_space(3)))

#define XB_TMO      128
#define XB_XCNT(j)  (256  + 64 * (j))
#define XB_XSUB(j)  (1280 + 64 * (j))
#define XB_XGEN(j)  (2304 + 64 * (j))
#define XB_TOP      3328
#define XB_TOPGEN   3392
#define XCD_BAR_WORDS 3456
#define XB_SPIN_CAP (1u << 22)

__device__ __forceinline__ unsigned xb_ld(unsigned* p)              { return __hip_atomic_load(p, __ATOMIC_RELAXED, __HIP_MEMORY_SCOPE_AGENT); }
__device__ __forceinline__ unsigned xb_add(unsigned* p, unsigned v) { return __hip_atomic_fetch_add(p, v, __ATOMIC_RELAXED, __HIP_MEMORY_SCOPE_AGENT); }
__device__ __forceinline__ unsigned xb_xcc_id() { return (unsigned)__builtin_amdgcn_s_getreg((3 << 11) | 20) & 0xFu; }
#define XB_SPIN(cond, bar) do { unsigned _sp = 0; while (cond) { __builtin_amdgcn_s_sleep(1); \
    if ((++_sp & 255u) == 0u) { if (xb_ld(&(bar)[XB_TMO])) break; if (_sp > XB_SPIN_CAP) { atomicAdd(&(bar)[XB_TMO], 1u); break; } } } } while (0)

struct XcdBarrier {
    unsigned* bar; unsigned x;
    volatile LAS unsigned* st;
};

__device__ __forceinline__ XcdBarrier xcd_barrier_post(unsigned* bar, volatile LAS unsigned* st) {
    XcdBarrier b; b.bar = bar; b.x = xb_xcc_id(); b.st = st;
    if (threadIdx.x == 0) (void)xb_add(&bar[XB_XCNT(b.x)], 1u);
    return b;
}
__device__ __forceinline__ void xcd_barrier_complete(unsigned* bar, unsigned x, unsigned& nloc, unsigned& nx) {
    const unsigned G = gridDim.x * gridDim.y * gridDim.z;
    unsigned sum, cnt, mine, sp = 0u;
    for (;;) {
        sum = 0u; cnt = 0u; mine = 0u;
#pragma unroll
        for (unsigned j = 0; j < 16; ++j) { const unsigned c = xb_ld(&bar[XB_XCNT(j)]); sum += c; cnt += (c > 0u) ? 1u : 0u; mine = (j == x) ? c : mine; }
        if (sum == G) break;
        __builtin_amdgcn_s_sleep(1);
        if ((++sp & 255u) == 0u) { if (xb_ld(&bar[XB_TMO])) break; if (sp > XB_SPIN_CAP) { atomicAdd(&bar[XB_TMO], 1u); break; } }
    }
    nloc = mine > 0u ? mine : 1u; nx = cnt > 0u ? cnt : 1u;
}

__device__ __forceinline__ void xcd_barrier(const XcdBarrier& b) {
    asm volatile("s_waitcnt vmcnt(0)" ::: "memory");
    __syncthreads();
    if (threadIdx.x == 0) {
        unsigned* bar = b.bar;
        __builtin_amdgcn_s_waitcnt(0);
        unsigned nloc = b.st[0], nx = b.st[1];
        if (nloc == 0u) { xcd_barrier_complete(bar, b.x, nloc, nx); b.st[0] = nloc; b.st[1] = nx; }
        const unsigned old = xb_add(&bar[XB_XSUB(b.x)], 1u);
        const unsigned gen = old / nloc;
        if (old + 1u == (gen + 1u) * nloc) {
            __builtin_amdgcn_fence(__ATOMIC_RELEASE, "agent");
            asm volatile("s_waitcnt vmcnt(0)" ::: "memory");
            const unsigned og = xb_add(&bar[XB_TOP], 1u);
            const unsigned tg = og / nx;
            if (og + 1u == (tg + 1u) * nx) xb_add(&bar[XB_TOPGEN], 1u);
            else XB_SPIN(xb_ld(&bar[XB_TOPGEN]) == tg, bar);
            __builtin_amdgcn_fence(__ATOMIC_ACQUIRE, "agent");
            xb_add(&bar[XB_XGEN(b.x)], 1u);
            asm volatile("s_waitcnt vmcnt(0)" ::: "memory");
        } else {
            XB_SPIN(xb_ld(&bar[XB_XGEN(b.x)]) == gen, bar);
            __builtin_amdgcn_fence(__ATOMIC_ACQUIRE, "agent");
            asm volatile("s_waitcnt vmcnt(0)" ::: "memory");
        }
    }
    __syncthreads();
}


using pg8::bf16_t; using pg8::bf16x8; using pg8::f32x4; using pg8::u32x4; using pg8::Unit;
#define DI __device__ __forceinline__
DI int opaque_tid() { int t = threadIdx.x; asm volatile("" : "+v"(t)); return t; }
typedef float f32x16 __attribute__((ext_vector_type(16)));
typedef short s16x4 __attribute__((ext_vector_type(4)));
typedef float f32x2 __attribute__((ext_vector_type(2)));
typedef unsigned u32x2 __attribute__((ext_vector_type(2)));
typedef __bf16 bf2_t __attribute__((ext_vector_type(2)));

constexpr int TOK = 32768, DM = 2048, SEQ = 2048, DFF = 8192;
constexpr size_t MiB = (size_t)1 << 20;
constexpr size_t WS_WQK = 0, WS_WV = 16 * MiB, WS_WOUT = 24 * MiB, WS_WFF1 = 32 * MiB, WS_WFF2 = 64 * MiB, WS_TABA = 96 * MiB, WS_TABB = 96 * MiB + 512 * 1024,
                 WS_STATS = 97 * MiB + 512 * 1024, WS_BAR = 97 * MiB + 768 * 1024, WS_X1B = 98 * MiB, WS_XB = 226 * MiB, WS_QK = 354 * MiB, WS_VT = 610 * MiB, WS_HDN = 226 * MiB, WS_END = 738 * MiB;
constexpr int LDS_BYTES = 131072;
constexpr int REP_P0 = 1, REP_P1 = 1, REP_ATT = 1, REP_P3 = 1, REP_LN1 = 1, REP_P5 = 1;
constexpr float DN_ALPHA = 1.189207115002721f;

DI unsigned pk_bf16(float lo, float hi) { f32x2 v = {lo, hi}; bf2_t b = __builtin_convertvector(v, bf2_t); return __builtin_bit_cast(unsigned, b); }
DI float bf_lo(unsigned w) { return __uint_as_float(w << 16); }
DI float bf_hi(unsigned w) { return __uint_as_float(w & 0xffff0000u); }
DI float xhalf_max(float v) { auto r = __builtin_amdgcn_permlane32_swap(__float_as_uint(v), __float_as_uint(v), false, false); return fmaxf(__uint_as_float(r[0]), __uint_as_float(r[1])); }
DI float xhalf_sum(float v) { auto r = __builtin_amdgcn_permlane32_swap(__float_as_uint(v), __float_as_uint(v), false, false); return __uint_as_float(r[0]) + __uint_as_float(r[1]); }
#define MFMA32(a, b, c) __builtin_amdgcn_mfma_f32_32x32x16_bf16((a), (b), (c), 0, 0, 0)

struct Params {
    const float* x; const float* w_in; const float* lq1; const float* lk1; const float* lq2; const float* lk2; const float* subg; const float* w_out;
    const float* ln1g; const float* ln1b; const float* w_ff1; const float* w_ff2; const float* ln2g; const float* ln2b; float* out; unsigned char* ws;
};

struct EpiRope {
    static constexpr bool PERM = true, AFTER_DRAIN = false;
    bf16_t* QK; const float* tabA; const float* tabB;
    DI void operator()(const f32x4 (&acc)[2][2][4][2], const Unit& u, int, int, int, int) const {
        const int t_ = opaque_tid(), wid_ = __builtin_amdgcn_readfirstlane(t_ >> 6), wr = wid_ >> 2, wc = wid_ & 3, fr = t_ & 15, fq = (t_ & 63) >> 4;
        const bool dil = (u.pn >> 2) >= 2;
        const int half = dil ? 64 : 32;
        const int lc0 = dil ? (128 * (wc >> 1) + 32 * (wc & 1) + 8 * fq) : (64 * wc + 8 * fq);
        const int ri0 = dil ? (32 * (wc & 1) + 8 * fq) : (8 * fq);
        const float* tab = dil ? tabB : tabA;
        const int row0 = u.pm * 256 + wr * 64 + fr;
        const int region = u.pn >> 2;
        const float osc = region == 0 ? 0.125f * 1.4426950408889634f : (region == 2 ? 0.08838834764831845f * 1.4426950408889634f : 1.0f);
        f32x4 tt[2][4];
        {
            const f32x4* tp = (const f32x4*)(tab + ((size_t)(row0 & (SEQ - 1)) * half + ri0) * 2);
            tt[0][0] = tp[0]; tt[0][1] = tp[1]; tt[0][2] = tp[2]; tt[0][3] = tp[3];
        }
#pragma unroll
        for (int it = 0; it < 8; ++it) {
            const int ai = it >> 2, m = it & 3;
            const int row = row0 + ai * 128 + m * 16;
            if (it + 1 < 8) {
                const int nrow = row0 + ((it + 1) >> 2) * 128 + ((it + 1) & 3) * 16;
                const f32x4* tp = (const f32x4*)(tab + ((size_t)(nrow & (SEQ - 1)) * half + ri0) * 2);
                tt[(it + 1) & 1][0] = tp[0]; tt[(it + 1) & 1][1] = tp[1]; tt[(it + 1) & 1][2] = tp[2]; tt[(it + 1) & 1][3] = tp[3];
            }
            float lo[8], hi[8];
#pragma unroll
            for (int n = 0; n < 2; ++n)
#pragma unroll
                for (int j = 0; j < 4; ++j) {
                    const int idx = 4 * n + j; const float c = tt[it & 1][idx >> 1][(idx & 1) * 2], s = tt[it & 1][idx >> 1][(idx & 1) * 2 + 1];
                    const float x0 = acc[ai][0][m][n][j], x1 = acc[ai][1][m][n][j];
                    lo[idx] = (x0 * c - x1 * s) * osc; hi[idx] = (x1 * c + x0 * s) * osc;
                }
            bf16_t* rp = QK + (size_t)row * 4096 + u.pn * 256 + lc0;
            u32x4 w0, w1;
            w0.x = pk_bf16(lo[0], lo[1]); w0.y = pk_bf16(lo[2], lo[3]); w0.z = pk_bf16(lo[4], lo[5]); w0.w = pk_bf16(lo[6], lo[7]);
            w1.x = pk_bf16(hi[0], hi[1]); w1.y = pk_bf16(hi[2], hi[3]); w1.z = pk_bf16(hi[4], hi[5]); w1.w = pk_bf16(hi[6], hi[7]);
            *(u32x4*)rp = w0; *(u32x4*)(rp + half) = w1;
        }
    }
};
template <int ACT  > struct EpiBf {
    static constexpr bool PERM = true, AFTER_DRAIN = false;
    bf16_t* O; int ldc;
    DI void operator()(const f32x4 (&acc)[2][2][4][2], const Unit& u, int, int, int, int) const {
        const int t_ = opaque_tid(), wid_ = __builtin_amdgcn_readfirstlane(t_ >> 6), wr = wid_ >> 2, wc = wid_ & 3, fr = t_ & 15, fq = (t_ & 63) >> 4;
        const int row0 = u.pm * 256 + wr * 64 + fr, col0 = u.pn * 256 + wc * 32 + 8 * fq;
#pragma unroll
        for (int ai = 0; ai < 2; ++ai)
#pragma unroll
            for (int m = 0; m < 4; ++m) {
                bf16_t* rowp = O + (size_t)(row0 + ai * 128 + m * 16) * ldc + col0;
#pragma unroll
                for (int bj = 0; bj < 2; ++bj) {
                    f32x4 v0 = acc[ai][bj][m][0], v1 = acc[ai][bj][m][1];
                    if (ACT == 1) {
#pragma unroll
                        for (int j = 0; j < 4; ++j) { const float a = fmaxf(v0[j], 0.f), b = fmaxf(v1[j], 0.f); v0[j] = a * a; v1[j] = b * b; }
                    }
                    u32x4 w; w.x = pk_bf16(v0[0], v0[1]); w.y = pk_bf16(v0[2], v0[3]); w.z = pk_bf16(v1[0], v1[1]); w.w = pk_bf16(v1[2], v1[3]);
                    *(u32x4*)(rowp + bj * 128) = w;
                }
            }
    }
};
struct EpiRes {
    static constexpr bool PERM = false, AFTER_DRAIN = false;
    const float* R; float* C; float scale;
    DI void operator()(const f32x4 (&acc)[2][2][4][2], const Unit& u, int, int, int, int) const {
        const int t_ = opaque_tid(), wid_ = __builtin_amdgcn_readfirstlane(t_ >> 6), wr = wid_ >> 2, wc = wid_ & 3, fr = t_ & 15, fq = (t_ & 63) >> 4;
        const int row0 = u.pm * 256 + wr * 64 + fr, col0 = u.pn * 256 + wc * 32 + 4 * fq;
#pragma unroll
        for (int ai = 0; ai < 2; ++ai)
#pragma unroll
            for (int m = 0; m < 4; ++m) {
                const size_t off = (size_t)(row0 + ai * 128 + m * 16) * DM + col0;
#pragma unroll
                for (int bj = 0; bj < 2; ++bj)
#pragma unroll
                    for (int n = 0; n < 2; ++n) {
                        const f32x4 rv = *(const f32x4*)(R + off + bj * 128 + n * 16);
                        *(f32x4*)(C + off + bj * 128 + n * 16) = rv * DN_ALPHA + acc[ai][bj][m][n] * scale;
                    }
            }
    }
};

struct EpiResBf {
    static constexpr bool PERM = true, AFTER_DRAIN = false;
    const float* R; bf16_t* Y;
    DI void operator()(const f32x4 (&acc)[2][2][4][2], const Unit& u, int, int, int, int) const {
        const int t_ = opaque_tid(), wid_ = __builtin_amdgcn_readfirstlane(t_ >> 6), wr = wid_ >> 2, wc = wid_ & 3, fr = t_ & 15, fq = (t_ & 63) >> 4;
        const int row0 = u.pm * 256 + wr * 64 + fr, col0 = u.pn * 256 + wc * 32 + 8 * fq;
#pragma unroll
        for (int ai = 0; ai < 2; ++ai)
#pragma unroll
            for (int m = 0; m < 4; ++m) {
                const size_t off = (size_t)(row0 + ai * 128 + m * 16) * DM + col0;
#pragma unroll
                for (int bj = 0; bj < 2; ++bj) {
                    const f32x4 r0 = *(const f32x4*)(R + off + bj * 128), r1 = *(const f32x4*)(R + off + bj * 128 + 4);
                    const f32x4 v0 = r0 * DN_ALPHA + acc[ai][bj][m][0], v1 = r1 * DN_ALPHA + acc[ai][bj][m][1];
                    u32x4 w; w.x = pk_bf16(v0[0], v0[1]); w.y = pk_bf16(v0[2], v0[3]); w.z = pk_bf16(v1[0], v1[1]); w.w = pk_bf16(v1[2], v1[3]);
                    *(u32x4*)(Y + off + bj * 128) = w;
                }
            }
    }
};
struct EpiResLnBf {
    static constexpr bool PERM = true, AFTER_DRAIN = false;
    const bf16_t* Y1; const float* stats; const float* g; const float* b; bf16_t* Y;
    DI void operator()(const f32x4 (&acc)[2][2][4][2], const Unit& u, int, int, int, int) const {
        const int t_ = opaque_tid(), wid_ = __builtin_amdgcn_readfirstlane(t_ >> 6), wr = wid_ >> 2, wc = wid_ & 3, fr = t_ & 15, fq = (t_ & 63) >> 4;
        const int row0 = u.pm * 256 + wr * 64 + fr, col0 = u.pn * 256 + wc * 32 + 8 * fq;
        f32x4 gg[2][2], bb[2][2];
#pragma unroll
        for (int bj = 0; bj < 2; ++bj)
#pragma unroll
            for (int n = 0; n < 2; ++n) { gg[bj][n] = *(const f32x4*)(g + col0 + bj * 128 + 4 * n); bb[bj][n] = *(const f32x4*)(b + col0 + bj * 128 + 4 * n); }
#pragma unroll
        for (int ai = 0; ai < 2; ++ai)
#pragma unroll
            for (int m = 0; m < 4; ++m) {
                const int row = row0 + ai * 128 + m * 16;
                const size_t off = (size_t)row * DM + col0;
                const f32x2 st = *(const f32x2*)(stats + 2 * row);
#pragma unroll
                for (int bj = 0; bj < 2; ++bj) {
                    const u32x4 yw = *(const u32x4*)(Y1 + off + bj * 128);
                    f32x4 v0, v1;
#pragma unroll
                    for (int j = 0; j < 2; ++j) {
                        v0[2 * j] = (bf_lo(yw[j]) - st[0]) * st[1] * gg[bj][0][2 * j] + bb[bj][0][2 * j];
                        v0[2 * j + 1] = (bf_hi(yw[j]) - st[0]) * st[1] * gg[bj][0][2 * j + 1] + bb[bj][0][2 * j + 1];
                        v1[2 * j] = (bf_lo(yw[2 + j]) - st[0]) * st[1] * gg[bj][1][2 * j] + bb[bj][1][2 * j];
                        v1[2 * j + 1] = (bf_hi(yw[2 + j]) - st[0]) * st[1] * gg[bj][1][2 * j + 1] + bb[bj][1][2 * j + 1];
                    }
                    v0 = v0 * DN_ALPHA + acc[ai][bj][m][0]; v1 = v1 * DN_ALPHA + acc[ai][bj][m][1];
                    u32x4 w; w.x = pk_bf16(v0[0], v0[1]); w.y = pk_bf16(v0[2], v0[3]); w.z = pk_bf16(v1[0], v1[1]); w.w = pk_bf16(v1[2], v1[3]);
                    *(u32x4*)(Y + off + bj * 128) = w;
                }
            }
    }
};

DI void tconv_tile(LAS unsigned char* lds, const float* src, int N, int K, bf16_t* dst, int p0, int c0, int k0) {
    const int tid = opaque_tid();
    LAS bf16_t* tile = (LAS bf16_t*)lds;
#pragma unroll
    for (int i = 0; i < 4; ++i) {
        const int u = tid + 512 * i, kl = u >> 3, c4 = (u & 7) * 4;
        const f32x4 v = __builtin_nontemporal_load((const f32x4*)(src + (size_t)(k0 + kl) * N + c0 + c4));
        const unsigned w0 = pk_bf16(v[0], v[1]), w1 = pk_bf16(v[2], v[3]);
        tile[(c4 + 0) * 264 + kl] = (bf16_t)(w0 & 0xffffu); tile[(c4 + 1) * 264 + kl] = (bf16_t)(w0 >> 16);
        tile[(c4 + 2) * 264 + kl] = (bf16_t)(w1 & 0xffffu); tile[(c4 + 3) * 264 + kl] = (bf16_t)(w1 >> 16);
    }
    __syncthreads();
#pragma unroll
    for (int i = 0; i < 2; ++i) {
        const int ch = tid + 512 * i, pr = ch >> 5, kc = (ch & 31) * 8;
        const u32x4 w = *(const LAS u32x4*)(lds + pr * 528 + kc * 2);
        *(u32x4*)(dst + (size_t)(p0 + pr) * K + k0 + kc) = w;
    }
    __syncthreads();
}
DI void sincos_d(double r, float& s, float& c) {
    const double r2 = r * r;
    double ts = 1.0, tc = 1.0, ss = 1.0, cs = 1.0;
#pragma unroll
    for (int n = 1; n <= 13; ++n) { tc = -tc * r2 * (1.0 / (double)((2 * n - 1) * (2 * n))); ts = -ts * r2 * (1.0 / (double)((2 * n) * (2 * n + 1))); cs += tc; ss += ts; }
    s = (float)(r * ss); c = (float)cs;
}
DI void p0_phase(LAS unsigned char* lds, const Params& p) {
    const int G = gridDim.x, bid = blockIdx.x, tid = opaque_tid();
    const size_t gtid = (size_t)bid * 512 + tid, gth = (size_t)G * 512;
    unsigned char* ws = p.ws;
    {
        const f32x4* xs = (const f32x4*)p.x; u32x4* xd = (u32x4*)(ws + WS_XB);
        constexpr size_t NV = (size_t)TOK * DM / 8;
        for (size_t i0 = gtid; i0 < NV; i0 += 4 * gth) {
            f32x4 a[4], b[4];
#pragma unroll
            for (int u = 0; u < 4; ++u) { const size_t i = i0 + u * gth; if (i < NV) { a[u] = __builtin_nontemporal_load(xs + 2 * i); b[u] = __builtin_nontemporal_load(xs + 2 * i + 1); } }
#pragma unroll
            for (int u = 0; u < 4; ++u) { const size_t i = i0 + u * gth; if (i < NV) { u32x4 w;
                w.x = pk_bf16(a[u][0], a[u][1]); w.y = pk_bf16(a[u][2], a[u][3]); w.z = pk_bf16(b[u][0], b[u][1]); w.w = pk_bf16(b[u][2], b[u][3]); xd[i] = w; } }
        }
    }
    {
        float* tabA = (float*)(ws + WS_TABA); float* tabB = (float*)(ws + WS_TABB);
        for (size_t idx = gtid; idx < (size_t)SEQ * 96; idx += gth) {
            const int pos = (int)(idx / 96), j = (int)(idx % 96);
            const bool dil = j >= 32; const int i = dil ? j - 32 : j;
            const float ex = dil ? (float)(2 * i) / 128.0f : (float)(2 * i) / 64.0f;
            const float inv = 1.0f / powf(10000.0f, ex);
            const float ang = (float)pos * inv;
            const double a = (double)ang; const double kk = rint(a * 0.15915494309189535);
            const double rr = a - kk * 6.283185307179586;
            float s, c; sincos_d(rr, s, c);
            float* d = dil ? tabB + ((size_t)pos * 64 + i) * 2 : tabA + ((size_t)pos * 32 + i) * 2;
            d[0] = c; d[1] = s;
        }
    }
    for (int t = bid; t < 6144; t += G) {
        const float* src; bf16_t* dst; int N, K, p0, c0, k0;
        if (t < 1024) {
            src = p.w_in; dst = (bf16_t*)(ws + WS_WQK); N = 6144; K = 2048; p0 = (t >> 3) * 32; k0 = (t & 7) * 256;
            const int pn = p0 >> 8, pp = p0 & 255, bj = pp >> 7, wc = (pp >> 5) & 3;
            const int lc = (pn >> 2) < 2 ? (64 * wc + 32 * bj) : (128 * (wc >> 1) + 64 * bj + 32 * (wc & 1));
            const int l = pn * 256 + lc; c0 = l < 2048 ? l : l + 1024;
        } else if (t < 1536) {
            const int tt = t - 1024; src = p.w_in; dst = (bf16_t*)(ws + WS_WV); N = 6144; K = 2048; p0 = (tt >> 3) * 32; k0 = (tt & 7) * 256;
            c0 = p0 < 1024 ? 2048 + p0 : 4096 + p0;
        } else if (t < 2048) {
            const int tt = t - 1536; src = p.w_out; dst = (bf16_t*)(ws + WS_WOUT); N = 2048; K = 2048; p0 = (tt >> 3) * 32; k0 = (tt & 7) * 256; c0 = p0;
        } else if (t < 4096) {
            const int tt = t - 2048; src = p.w_ff1; dst = (bf16_t*)(ws + WS_WFF1); N = 8192; K = 2048; p0 = (tt >> 3) * 32; k0 = (tt & 7) * 256; c0 = p0;
        } else {
            const int tt = t - 4096; src = p.w_ff2; dst = (bf16_t*)(ws + WS_WFF2); N = 2048; K = 8192; p0 = (tt >> 5) * 32; k0 = (tt & 31) * 256; c0 = p0;
        }
        tconv_tile(lds, src, N, K, dst, p0, c0, k0);
    }
}

constexpr int A_KP = 272, A_VP = 144, A_KB = 64 * A_KP, A_VB = 128 * A_VP, A_BUF = A_KB + A_VB, A_TBL = 2 * A_BUF, A_TBL_N = 2176;
constexpr float LOG2E = 1.4426950408889634f;

struct AItem { const bf16_t* Qb; const bf16_t* Kb; const bf16_t* VTb; bf16_t* Mb; int qb, type; };
DI void attn_preload(const AItem& it, bf16x8 (&qa)[4], bf16x8 (&qb4)[4], u32x4 (&kr)[2], u32x4 (&vr)[2]) {
    const int tid = opaque_tid(), lane = tid & 63, w = __builtin_amdgcn_readfirstlane(tid >> 6), r = lane & 31, h = lane >> 5;
    const bf16_t* qrow = it.Qb + (size_t)(it.qb * 256 + w * 32 + r) * 4096 + h * 8;
#pragma unroll
    for (int ks = 0; ks < 4; ++ks) { qa[ks] = *(const bf16x8*)(qrow + ks * 16); qb4[ks] = *(const bf16x8*)(qrow + 64 + ks * 16); }
    const int k_row0 = tid >> 4, k_c = tid & 15, v_row0 = tid >> 3, v_c = tid & 7;
#pragma unroll
    for (int i = 0; i < 2; ++i) {
        kr[i] = *(const u32x4*)(it.Kb + (size_t)(k_row0 + i * 32) * 4096 + k_c * 8);
        vr[i] = *(const u32x4*)(it.VTb + (size_t)(v_row0 + i * 64) * 32768 + v_c * 8);
    }
}
#define QF(i_) ((i_) < 4 ? qa[(i_) & 3] : qb4[(i_) & 3])
template <bool DIL>
DI void attn_item(LAS unsigned char* lds, const bf16_t* Qb, const bf16_t* Kb, const bf16_t* VTb, bf16_t* Mb, int qb, float lam, const float* subg,
                  bf16x8 (&qa)[4], bf16x8 (&qb4)[4], u32x4 (&kr)[2], u32x4 (&vr)[2], bool has_next, const AItem& nxt) {
    const int tid = opaque_tid(), lane = tid & 63, w = __builtin_amdgcn_readfirstlane(tid >> 6), r = lane & 31, h = lane >> 5;
    const int q0w = qb * 256 + w * 32;
    const int nt = 4 * qb + 4;
    const int k_row0 = tid >> 4, k_c = tid & 15, v_row0 = tid >> 3, v_c = tid & 7;
    const bf16_t* kg = Kb + (size_t)k_row0 * 4096 + k_c * 8;
    const bf16_t* vg = VTb + (size_t)v_row0 * 32768 + v_c * 8;
    const unsigned k_l = k_row0 * A_KP + k_c * 16, v_l = A_KB + v_row0 * A_VP + (v_c >> 1) * 32 + (v_c & 1) * 8;
    const unsigned ka_off = r * A_KP + h * 16, va_off = A_KB + r * A_VP + h * 16;
    constexpr int NPASS = DIL ? 1 : 2, NKS = DIL ? 8 : 4;
#pragma unroll
    for (int pass = 0; pass < NPASS; ++pass) {
        f32x16 oacc[4];
#pragma unroll
        for (int db = 0; db < 4; ++db)
#pragma unroll
            for (int i = 0; i < 16; ++i) oacc[db][i] = 0.f;
        float m_run = 0.f, l_run = 0.f;
#define A_LOAD(kt) do { _Pragma("unroll") for (int i_ = 0; i_ < 2; ++i_) { \
            kr[i_] = *(const u32x4*)(kg + (size_t)((kt) * 64 + i_ * 32) * 4096); \
            vr[i_] = *(const u32x4*)(vg + (size_t)(i_ * 64) * 32768 + (kt) * 64); } } while (0)
#define A_STORE(buf) do { LAS unsigned char* b_ = lds + (buf) * A_BUF; _Pragma("unroll") for (int i_ = 0; i_ < 2; ++i_) { \
            *(LAS u32x4*)(b_ + k_l + i_ * 32 * A_KP) = kr[i_]; \
            u32x2 lo_ = {vr[i_].x, vr[i_].y}, hi_ = {vr[i_].z, vr[i_].w}; \
            *(LAS u32x2*)(b_ + v_l + i_ * 64 * A_VP) = lo_; *(LAS u32x2*)(b_ + v_l + i_ * 64 * A_VP + 16) = hi_; } } while (0)
        A_STORE(0); __syncthreads();
        for (int kt = 0; kt < nt; ++kt) {
            const int cur = kt & 1;
            if (kt + 1 < nt) A_LOAD(kt + 1);
            if (kt * 64 <= q0w + 31) {
                LAS unsigned char* bp = lds + cur * A_BUF;
                f32x16 s0, s1;
                const float sinit = -m_run;
#pragma unroll
                for (int i = 0; i < 16; ++i) { s0[i] = sinit; s1[i] = sinit; }
                {
                    bf16x8 kf[2][4];
#define A_LDK(g_, d_) do { _Pragma("unroll") for (int q_ = 0; q_ < 4; ++q_) d_[q_] = *(const LAS bf16x8*)(bp + ka_off + (q_ & 1) * 32 * A_KP + pass * 128 + (2 * (g_) + (q_ >> 1)) * 32); } while (0)
                    A_LDK(0, kf[0]);
                    __builtin_amdgcn_s_setprio(1);
#pragma unroll
                    for (int g = 0; g < NKS / 2; ++g) {
                        if (g + 1 < NKS / 2) A_LDK(g + 1, kf[(g + 1) & 1]);
                        __builtin_amdgcn_sched_barrier(0);
                        s0 = MFMA32(kf[g & 1][0], QF(2 * g), s0); s1 = MFMA32(kf[g & 1][1], QF(2 * g), s1);
                        s0 = MFMA32(kf[g & 1][2], QF(2 * g + 1), s0); s1 = MFMA32(kf[g & 1][3], QF(2 * g + 1), s1);
                        __builtin_amdgcn_sched_barrier(0);
                    }
#undef A_LDK
                    __builtin_amdgcn_s_setprio(0);
                }
                const int base = q0w + r - 4 * h - kt * 64;
                float mx = -1e30f;
                if (DIL) {
                    const LAS float* tb = (const LAS float*)(lds + A_TBL) + (base + 65);
#pragma unroll
                    for (int kb = 0; kb < 2; ++kb)
#pragma unroll
                        for (int i = 0; i < 16; ++i) {
                            const float bias = tb[63 - (32 * kb + (i & 3) + 8 * (i >> 2))];
                            const float t = (kb ? s1[i] : s0[i]) + bias;
                            if (kb) s1[i] = t; else s0[i] = t;
                            mx = fmaxf(mx, t);
                        }
                } else if (kt * 64 + 63 > q0w) {
#pragma unroll
                    for (int kb = 0; kb < 2; ++kb)
#pragma unroll
                        for (int i = 0; i < 16; ++i) {
                            const int dlt = base - (32 * kb + (i & 3) + 8 * (i >> 2));
                            const float t = dlt >= 0 ? (kb ? s1[i] : s0[i]) : -1e30f;
                            if (kb) s1[i] = t; else s0[i] = t;
                            mx = fmaxf(mx, t);
                        }
                } else {
#pragma unroll
                    for (int i = 0; i < 16; ++i) mx = fmaxf(mx, fmaxf(s0[i], s1[i]));
                }
                mx = xhalf_max(mx);
                if (kt == 0 || __any(mx > 8.0f)) {
                    const float delta = kt == 0 ? mx : fmaxf(mx, 0.f);
                    m_run += delta;
                    if (kt != 0) {
                        const float alpha = __builtin_amdgcn_exp2f(-delta);
                        l_run *= alpha;
#pragma unroll
                        for (int db = 0; db < 4; ++db)
#pragma unroll
                            for (int i = 0; i < 16; ++i) oacc[db][i] *= alpha;
                    }
#pragma unroll
                    for (int i = 0; i < 16; ++i) { s0[i] -= delta; s1[i] -= delta; }
                }
                float ls = 0.f, ls2 = 0.f;
#pragma unroll
                for (int i = 0; i < 16; ++i) { const float p0 = __builtin_amdgcn_exp2f(s0[i]), p1 = __builtin_amdgcn_exp2f(s1[i]); s0[i] = p0; s1[i] = p1; ls += p0; asm volatile("" : "+v"(ls)); ls2 += p1; asm volatile("" : "+v"(ls2)); }
                l_run += ls + ls2;
                {
                    u32x4 pw[4];
#pragma unroll
                    for (int s = 0; s < 2; ++s) {
                        pw[s].x = pk_bf16(s0[8 * s + 0], s0[8 * s + 1]); pw[s].y = pk_bf16(s0[8 * s + 2], s0[8 * s + 3]); pw[s].z = pk_bf16(s0[8 * s + 4], s0[8 * s + 5]); pw[s].w = pk_bf16(s0[8 * s + 6], s0[8 * s + 7]);
                        pw[2 + s].x = pk_bf16(s1[8 * s + 0], s1[8 * s + 1]); pw[2 + s].y = pk_bf16(s1[8 * s + 2], s1[8 * s + 3]); pw[2 + s].z = pk_bf16(s1[8 * s + 4], s1[8 * s + 5]); pw[2 + s].w = pk_bf16(s1[8 * s + 6], s1[8 * s + 7]);
                    }
                    bf16x8 vf[2][4];
#define A_LDV(g_, d_) do { _Pragma("unroll") for (int db = 0; db < 4; ++db) { \
                        d_[db] = *(const LAS bf16x8*)(bp + va_off + db * 32 * A_VP + (g_) * 32); } } while (0)
                    A_LDV(0, vf[0]);
                    __builtin_amdgcn_s_setprio(1);
#pragma unroll
                    for (int g = 0; g < 4; ++g) {
                        if (g + 1 < 4) A_LDV(g + 1, vf[(g + 1) & 1]);
                        __builtin_amdgcn_sched_barrier(0);
                        const bf16x8 pb = __builtin_bit_cast(bf16x8, pw[g]);
#pragma unroll
                        for (int db = 0; db < 4; ++db) oacc[db] = MFMA32(vf[g & 1][db], pb, oacc[db]);
                        __builtin_amdgcn_sched_barrier(0);
                    }
#undef A_LDV
                    __builtin_amdgcn_s_setprio(0);
                }
            }
            if (kt + 1 < nt) A_STORE(cur ^ 1);
            __syncthreads();
        }
#undef A_LOAD
#undef A_STORE
        if (has_next) attn_preload(nxt, qa, qb4, kr, vr);
        const float l_tot = xhalf_sum(l_run);
        bf16_t* mp = Mb + (size_t)(q0w + r) * DM + 4 * h;
        if (DIL) {
            const float inv = 1.0f / l_tot;
#pragma unroll
            for (int db = 0; db < 4; ++db)
#pragma unroll
                for (int g = 0; g < 4; ++g) {
                    u32x2 wv; wv.x = pk_bf16(oacc[db][4 * g] * inv, oacc[db][4 * g + 1] * inv); wv.y = pk_bf16(oacc[db][4 * g + 2] * inv, oacc[db][4 * g + 3] * inv);
                    *(u32x2*)(mp + 32 * db + 8 * g) = wv;
                }
        } else if (pass == 0) {
            const float inv = 1.0f / l_tot;
#pragma unroll
            for (int db = 0; db < 4; ++db)
#pragma unroll
                for (int g = 0; g < 4; ++g) {
                    u32x2 wv; wv.x = pk_bf16(oacc[db][4 * g] * inv, oacc[db][4 * g + 1] * inv); wv.y = pk_bf16(oacc[db][4 * g + 2] * inv, oacc[db][4 * g + 3] * inv);
                    *(u32x2*)(mp + 32 * db + 8 * g) = wv;
                }
        } else {
            const float inv2 = lam / l_tot;
            float ss = 0.f;
#pragma unroll
            for (int db = 0; db < 4; ++db)
#pragma unroll
                for (int g = 0; g < 4; ++g) {
                    const u32x2 o1 = *(const volatile u32x2*)(mp + 32 * db + 8 * g);
                    const float a0 = bf_lo(o1.x) - oacc[db][4 * g] * inv2, a1 = bf_hi(o1.x) - oacc[db][4 * g + 1] * inv2;
                    const float a2 = bf_lo(o1.y) - oacc[db][4 * g + 2] * inv2, a3 = bf_hi(o1.y) - oacc[db][4 * g + 3] * inv2;
                    oacc[db][4 * g] = a0; oacc[db][4 * g + 1] = a1; oacc[db][4 * g + 2] = a2; oacc[db][4 * g + 3] = a3;
                    ss += a0 * a0 + a1 * a1 + a2 * a2 + a3 * a3;
                }
            ss = xhalf_sum(ss);
            const float rn = __builtin_amdgcn_rsqf(ss * (1.0f / 128.0f) + 1e-5f) * 0.8f;
#pragma unroll
            for (int db = 0; db < 4; ++db)
#pragma unroll
                for (int g = 0; g < 4; ++g) {
                    const f32x4 gv = *(const f32x4*)(subg + 32 * db + 8 * g + 4 * h);
                    u32x2 wv; wv.x = pk_bf16(oacc[db][4 * g] * rn * gv[0], oacc[db][4 * g + 1] * rn * gv[1]); wv.y = pk_bf16(oacc[db][4 * g + 2] * rn * gv[2], oacc[db][4 * g + 3] * rn * gv[3]);
                    *(u32x2*)(mp + 32 * db + 8 * g) = wv;
                }
        }
    }
}
DI void diff_scores(LAS unsigned char* bp, unsigned koff, const bf16x8 (&qf)[4], bool diag, bool first, int base, float& m_run, float& l_run, f32x16 (&oacc)[4], u32x4 (&pw)[4]) {
    f32x16 s0, s1;
    const float sinit = -m_run;
#pragma unroll
    for (int i = 0; i < 16; ++i) { s0[i] = sinit; s1[i] = sinit; }
    __builtin_amdgcn_s_setprio(1);
#pragma unroll
    for (int ks = 0; ks < 4; ++ks) {
        const bf16x8 a0 = *(const LAS bf16x8*)(bp + koff + ks * 32);
        const bf16x8 a1 = *(const LAS bf16x8*)(bp + koff + 32 * A_KP + ks * 32);
        s0 = MFMA32(a0, qf[ks], s0); s1 = MFMA32(a1, qf[ks], s1);
    }
    __builtin_amdgcn_s_setprio(0);
    float mx = -1e30f;
    if (diag) {
#pragma unroll
        for (int kb = 0; kb < 2; ++kb)
#pragma unroll
            for (int i = 0; i < 16; ++i) {
                const int dlt = base - (32 * kb + (i & 3) + 8 * (i >> 2));
                const float t = dlt >= 0 ? (kb ? s1[i] : s0[i]) : -1e30f;
                if (kb) s1[i] = t; else s0[i] = t;
                mx = fmaxf(mx, t);
            }
    } else {
#pragma unroll
        for (int i = 0; i < 16; ++i) mx = fmaxf(mx, fmaxf(s0[i], s1[i]));
    }
    mx = xhalf_max(mx);
    if (first || __any(mx > 8.0f)) {
        const float delta = first ? mx : fmaxf(mx, 0.f);
        m_run += delta;
        if (!first) {
            const float alpha = __builtin_amdgcn_exp2f(-delta);
            l_run *= alpha;
#pragma unroll
            for (int db = 0; db < 4; ++db)
#pragma unroll
                for (int i = 0; i < 16; ++i) oacc[db][i] *= alpha;
        }
#pragma unroll
        for (int i = 0; i < 16; ++i) { s0[i] -= delta; s1[i] -= delta; }
    }
    float ls = 0.f, ls2 = 0.f;
#pragma unroll
    for (int i = 0; i < 16; ++i) { const float p0 = __builtin_amdgcn_exp2f(s0[i]), p1 = __builtin_amdgcn_exp2f(s1[i]); s0[i] = p0; s1[i] = p1; ls += p0; asm volatile("" : "+v"(ls)); ls2 += p1; asm volatile("" : "+v"(ls2)); }
    l_run += ls + ls2;
#pragma unroll
    for (int s = 0; s < 2; ++s) {
        pw[s].x = pk_bf16(s0[8 * s + 0], s0[8 * s + 1]); pw[s].y = pk_bf16(s0[8 * s + 2], s0[8 * s + 3]); pw[s].z = pk_bf16(s0[8 * s + 4], s0[8 * s + 5]); pw[s].w = pk_bf16(s0[8 * s + 6], s0[8 * s + 7]);
        pw[2 + s].x = pk_bf16(s1[8 * s + 0], s1[8 * s + 1]); pw[2 + s].y = pk_bf16(s1[8 * s + 2], s1[8 * s + 3]); pw[2 + s].z = pk_bf16(s1[8 * s + 4], s1[8 * s + 5]); pw[2 + s].w = pk_bf16(s1[8 * s + 6], s1[8 * s + 7]);
    }
}
DI void attn_item_diff(LAS unsigned char* lds, const bf16_t* Qb, const bf16_t* Kb, const bf16_t* VTb, bf16_t* Mb, int qb, float lam, const float* subg,
                       bf16x8 (&qa)[4], bf16x8 (&qb4)[4], u32x4 (&kr)[2], u32x4 (&vr)[2], bool has_next, const AItem& nxt) {
    const int tid = opaque_tid(), lane = tid & 63, w = __builtin_amdgcn_readfirstlane(tid >> 6), r = lane & 31, h = lane >> 5;
    const int q0w = qb * 256 + w * 32;
    const int nt = 4 * qb + 4;
    const int k_row0 = tid >> 4, k_c = tid & 15, v_row0 = tid >> 3, v_c = tid & 7;
    const bf16_t* kg = Kb + (size_t)k_row0 * 4096 + k_c * 8;
    const bf16_t* vg = VTb + (size_t)v_row0 * 32768 + v_c * 8;
    const unsigned k_l = k_row0 * A_KP + k_c * 16, v_l = A_KB + v_row0 * A_VP + (v_c >> 1) * 32 + (v_c & 1) * 8;
    const unsigned ka_off = r * A_KP + h * 16, va_off = A_KB + r * A_VP + h * 16;
    f32x16 oa[4], ob[4];
#pragma unroll
    for (int db = 0; db < 4; ++db)
#pragma unroll
        for (int i = 0; i < 16; ++i) { oa[db][i] = 0.f; ob[db][i] = 0.f; }
    float m1 = 0.f, m2 = 0.f, l1 = 0.f, l2 = 0.f;
#define D_LOAD(kt) do { _Pragma("unroll") for (int i_ = 0; i_ < 2; ++i_) { \
        kr[i_] = *(const u32x4*)(kg + (size_t)((kt) * 64 + i_ * 32) * 4096); \
        vr[i_] = *(const u32x4*)(vg + (size_t)(i_ * 64) * 32768 + (kt) * 64); } } while (0)
#define D_STORE(buf) do { LAS unsigned char* b_ = lds + (buf) * A_BUF; _Pragma("unroll") for (int i_ = 0; i_ < 2; ++i_) { \
        *(LAS u32x4*)(b_ + k_l + i_ * 32 * A_KP) = kr[i_]; \
        u32x2 lo_ = {vr[i_].x, vr[i_].y}, hi_ = {vr[i_].z, vr[i_].w}; \
        *(LAS u32x2*)(b_ + v_l + i_ * 64 * A_VP) = lo_; *(LAS u32x2*)(b_ + v_l + i_ * 64 * A_VP + 16) = hi_; } } while (0)
    D_STORE(0); __syncthreads();
    for (int kt = 0; kt < nt; ++kt) {
        const int cur = kt & 1;
        if (kt + 1 < nt) D_LOAD(kt + 1);
        if (kt * 64 <= q0w + 31) {
            LAS unsigned char* bp = lds + cur * A_BUF;
            const bool diag = kt * 64 + 63 > q0w;
            const int base = q0w + r - 4 * h - kt * 64;
            u32x4 pw[4];
#define D_PV(acc_) do { __builtin_amdgcn_s_setprio(1); _Pragma("unroll") for (int g = 0; g < 4; ++g) { \
                const bf16x8 pb_ = __builtin_bit_cast(bf16x8, pw[g]); \
                _Pragma("unroll") for (int db = 0; db < 4; ++db) { \
                    const bf16x8 va_ = *(const LAS bf16x8*)(bp + va_off + db * 32 * A_VP + g * 32); \
                    acc_[db] = MFMA32(va_, pb_, acc_[db]); } } \
                __builtin_amdgcn_s_setprio(0); } while (0)
            diff_scores(bp, ka_off, qa, diag, kt == 0, base, m1, l1, oa, pw);
            D_PV(oa);
            diff_scores(bp, ka_off + 128, qb4, diag, kt == 0, base, m2, l2, ob, pw);
            D_PV(ob);
#undef D_PV
        }
        if (kt + 1 < nt) D_STORE(cur ^ 1);
        __syncthreads();
    }
#undef D_LOAD
#undef D_STORE
    if (has_next) attn_preload(nxt, qa, qb4, kr, vr);
    const float inv1 = 1.0f / xhalf_sum(l1), inv2 = lam / xhalf_sum(l2);
    bf16_t* mp = Mb + (size_t)(q0w + r) * DM + 4 * h;
    float ss = 0.f;
#pragma unroll
    for (int db = 0; db < 4; ++db)
#pragma unroll
        for (int i = 0; i < 16; ++i) { const float a = oa[db][i] * inv1 - ob[db][i] * inv2; oa[db][i] = a; ss += a * a; }
    ss = xhalf_sum(ss);
    const float rn = __builtin_amdgcn_rsqf(ss * (1.0f / 128.0f) + 1e-5f) * 0.8f;
#pragma unroll
    for (int db = 0; db < 4; ++db)
#pragma unroll
        for (int g = 0; g < 4; ++g) {
            const f32x4 gv = *(const f32x4*)(subg + 32 * db + 8 * g + 4 * h);
            u32x2 wv; wv.x = pk_bf16(oa[db][4 * g] * rn * gv[0], oa[db][4 * g + 1] * rn * gv[1]); wv.y = pk_bf16(oa[db][4 * g + 2] * rn * gv[2], oa[db][4 * g + 3] * rn * gv[3]);
            *(u32x2*)(mp + 32 * db + 8 * g) = wv;
        }
}
DI void attn_phase(LAS unsigned char* lds, const Params& p) {
    float d1 = 0.f, d2 = 0.f;
    for (int i = 0; i < 64; ++i) { d1 += p.lq1[i] * p.lk1[i]; d2 += p.lq2[i] * p.lk2[i]; }
    const float lam = __expf(d1) - __expf(d2) + 0.2f;
    const bf16_t* QK = (const bf16_t*)(p.ws + WS_QK); const bf16_t* VT = (const bf16_t*)(p.ws + WS_VT); bf16_t* MIX = (bf16_t*)(p.ws + WS_XB);
    {
        LAS float* tb = (LAS float*)(lds + A_TBL);
        for (int idx = opaque_tid(); idx < A_TBL_N; idx += 512) {
            const int dlt = idx - 128;
            const int cnt = (dlt <= 128 ? 1 : 0) + ((((dlt & 3) == 0) && dlt <= 512) ? 1 : 0) + (((dlt & 15) == 0) ? 1 : 0);
            tb[idx] = (dlt < 0 || cnt == 0) ? -1e30f : (cnt == 3 ? 1.5849625007211562f : (cnt == 2 ? 1.0f : 0.0f));
        }
        __syncthreads();
    }
    const int nit = blockIdx.x < 1024 ? 2 * ((1024 - (int)blockIdx.x + (int)gridDim.x - 1) / (int)gridDim.x) : 0;
    auto desc = [&](int j) {
        const int idx = blockIdx.x + (j >> 1) * gridDim.x;
        const int rr = idx >> 8, v = idx & 255, x = v & 7, s = v >> 3, gq = s >> 2, mm = s & 3;
        const int combo = rr * 64 + x * 8 + gq;
        const int type = combo >> 7, b = (combo >> 3) & 15, hh = combo & 7;
        AItem it;
        it.Qb = QK + (size_t)b * SEQ * 4096 + type * 2048 + hh * 128; it.Kb = it.Qb + 1024;
        it.VTb = VT + (size_t)(type * 1024 + hh * 128) * TOK + b * SEQ;
        it.Mb = MIX + (size_t)b * SEQ * DM + type * 1024 + hh * 128;
        it.qb = (j & 1) ? mm : 7 - mm; it.type = type;
        return it;
    };
    bf16x8 qa[4], qb4[4]; u32x4 kr[2], vr[2];
    if (nit > 0) { const AItem it0 = desc(0); attn_preload(it0, qa, qb4, kr, vr); }
#pragma unroll 1
    for (int j = 0; j < nit; ++j) {
        const AItem it = desc(j);
        const bool hn = j + 1 < nit;
        const AItem nx = desc(hn ? j + 1 : j);
        if (it.type) attn_item<true>(lds, it.Qb, it.Kb, it.VTb, it.Mb, it.qb, lam, p.subg, qa, qb4, kr, vr, hn, nx);
        else attn_item_diff(lds, it.Qb, it.Kb, it.VTb, it.Mb, it.qb, lam, p.subg, qa, qb4, kr, vr, hn, nx);
    }
}

DI float wave_sum(float v) {
#pragma unroll
    for (int o = 32; o >= 1; o >>= 1) v += __shfl_xor(v, o);
    return v;
}
DI void ln_phase(const bf16_t* in, float* of, bf16_t* ob, float* stats, const float* g, const float* b) {
    const int tid = opaque_tid(); const int lane = tid & 63, gw = blockIdx.x * 8 + (tid >> 6), nw = gridDim.x * 8;
    u32x4 nx[4];
    if (gw < TOK) {
#pragma unroll
        for (int i = 0; i < 4; ++i) nx[i] = __builtin_nontemporal_load((const u32x4*)(in + (size_t)gw * DM + i * 512 + lane * 8));
    }
    for (int row = gw; row < TOK; row += nw) {
        float v[32]; float s = 0.f;
#pragma unroll
        for (int i = 0; i < 4; ++i)
#pragma unroll
            for (int j = 0; j < 4; ++j) { v[8 * i + 2 * j] = bf_lo(nx[i][j]); v[8 * i + 2 * j + 1] = bf_hi(nx[i][j]); s += v[8 * i + 2 * j] + v[8 * i + 2 * j + 1]; }
        if (row + nw < TOK) {
#pragma unroll
            for (int i = 0; i < 4; ++i) nx[i] = __builtin_nontemporal_load((const u32x4*)(in + (size_t)(row + nw) * DM + i * 512 + lane * 8));
        }
        const float mean = wave_sum(s) * (1.0f / DM);
        float q = 0.f;
#pragma unroll
        for (int e = 0; e < 32; ++e) { const float d = v[e] - mean; q += d * d; }
        const float rstd = 1.0f / sqrtf(wave_sum(q) * (1.0f / DM) + 1e-5f);
        if (stats && lane == 0) { f32x2 st = {mean, rstd}; *(f32x2*)(stats + 2 * row) = st; }
#pragma unroll
        for (int i = 0; i < 4; ++i) {
            const int c = i * 512 + lane * 8;
            const f32x4 g0 = *(const f32x4*)(g + c), g1 = *(const f32x4*)(g + c + 4), b0 = *(const f32x4*)(b + c), b1 = *(const f32x4*)(b + c + 4);
            f32x4 y0, y1;
#pragma unroll
            for (int j = 0; j < 4; ++j) { y0[j] = (v[8 * i + j] - mean) * rstd * g0[j] + b0[j]; y1[j] = (v[8 * i + 4 + j] - mean) * rstd * g1[j] + b1[j]; }
            if (of) { __builtin_nontemporal_store(y0, (f32x4*)(of + (size_t)row * DM + c)); __builtin_nontemporal_store(y1, (f32x4*)(of + (size_t)row * DM + c + 4)); }
            if (ob) { u32x4 wv; wv.x = pk_bf16(y0[0], y0[1]); wv.y = pk_bf16(y0[2], y0[3]); wv.z = pk_bf16(y1[0], y1[1]); wv.w = pk_bf16(y1[2], y1[3]); *(u32x4*)(ob + (size_t)row * DM + c) = wv; }
        }
    }
}

typedef const __attribute__((address_space(4))) Params* KParamsPtr;
DI Params load_params() {
#if defined(__HIP_DEVICE_COMPILE__)
    unsigned long long a = (unsigned long long)__builtin_amdgcn_kernarg_segment_ptr();
    asm volatile("" : "+s"(a));
    KParamsPtr kp = (KParamsPtr)a;
    Params r;
    r.x = kp->x; r.w_in = kp->w_in; r.lq1 = kp->lq1; r.lk1 = kp->lk1; r.lq2 = kp->lq2; r.lk2 = kp->lk2; r.subg = kp->subg; r.w_out = kp->w_out;
    r.ln1g = kp->ln1g; r.ln1b = kp->ln1b; r.w_ff1 = kp->w_ff1; r.w_ff2 = kp->w_ff2; r.ln2g = kp->ln2g; r.ln2b = kp->ln2b; r.out = kp->out; r.ws = kp->ws;
    return r;
#else
    return Params{};
#endif
}
#define PHASE_PARAMS() const Params p = load_params(); unsigned char* ws = p.ws; \
    bf16_t* XB = (bf16_t*)(ws + WS_XB); bf16_t* QK = (bf16_t*)(ws + WS_QK); bf16_t* VT = (bf16_t*)(ws + WS_VT); bf16_t* X1B = (bf16_t*)(ws + WS_X1B); bf16_t* HDN = (bf16_t*)(ws + WS_HDN); \
    (void)XB; (void)QK; (void)VT; (void)X1B; (void)HDN
__global__ void __launch_bounds__(512, 2) fwd_megakernel(Params p_in) {
    extern __shared__ __attribute__((aligned(16))) unsigned char lds_raw[];
    LAS unsigned char* lds = (LAS unsigned char*)lds_raw;
    cg::grid_group grid = cg::this_grid();
    __shared__ __attribute__((aligned(16))) unsigned xb_st[4];
    if (threadIdx.x < 4) xb_st[threadIdx.x] = 0u;
    __syncthreads();
    const XcdBarrier xbar = xcd_barrier_post((unsigned*)(p_in.ws + WS_BAR), (volatile LAS unsigned*)xb_st);
    const int G = gridDim.x, bid = blockIdx.x;

    { PHASE_PARAMS(); p0_phase(lds, p); __syncthreads(); }
    grid.sync();
    {
        PHASE_PARAMS();
        pg8::Gemm g{XB, (const bf16_t*)(ws + WS_WQK), TOK, 4096, DM}; pg8::StaticOrder S; S.init(TOK, 4096, G, bid);
        EpiRope E{QK, (const float*)(ws + WS_TABA), (const float*)(ws + WS_TABB)};
        pg8::gemm_phase<EpiRope, pg8::StaticOrder>(lds, g, S, E, nullptr);
    }
    {
        PHASE_PARAMS();
        pg8::Gemm g{(const bf16_t*)(ws + WS_WV), XB, 2048, TOK, DM}; pg8::StaticOrder S; S.init(2048, TOK, G, bid);
        EpiBf<0> E{VT, TOK};
        pg8::gemm_phase<EpiBf<0>, pg8::StaticOrder>(lds, g, S, E, nullptr);
    }
    xcd_barrier(xbar);
    { PHASE_PARAMS(); attn_phase(lds, p); }
    xcd_barrier(xbar);
    {
        PHASE_PARAMS();
        pg8::Gemm g{XB, (const bf16_t*)(ws + WS_WOUT), TOK, DM, DM}; pg8::StaticOrder S; S.init(TOK, DM, G, bid);
        EpiResBf E{p.x, (bf16_t*)p.out};
        pg8::gemm_phase<EpiResBf, pg8::StaticOrder>(lds, g, S, E, nullptr);
    }
    xcd_barrier(xbar);
    { PHASE_PARAMS(); ln_phase((const bf16_t*)p.out, nullptr, X1B, (float*)(ws + WS_STATS), p.ln1g, p.ln1b); }
    xcd_barrier(xbar);
    {
        PHASE_PARAMS();
        pg8::Gemm g{X1B, (const bf16_t*)(ws + WS_WFF1), TOK, DFF, DM}; pg8::StaticOrder S; S.init(TOK, DFF, G, bid);
        EpiBf<1> E{HDN, DFF};
        pg8::gemm_phase<EpiBf<1>, pg8::StaticOrder>(lds, g, S, E, nullptr);
    }
    xcd_barrier(xbar);
    {
        PHASE_PARAMS();
        pg8::Gemm g{HDN, (const bf16_t*)(ws + WS_WFF2), TOK, DM, DFF}; pg8::StaticOrder S; S.init(TOK, DM, G, bid);
        EpiResLnBf E{(const bf16_t*)p.out, (const float*)(ws + WS_STATS), p.ln1g, p.ln1b, X1B};
        pg8::gemm_phase<EpiResLnBf, pg8::StaticOrder>(lds, g, S, E, nullptr);
    }
    xcd_barrier(xbar);
    { PHASE_PARAMS(); ln_phase(X1B, p.out, nullptr, nullptr, p.ln2g, p.ln2b); }
}

extern "C" void kernel_launch(void* const* d_in, const int* in_sizes, int n_in, void* d_out, int out_size, void* d_ws, size_t ws_size, hipStream_t stream) {
    static int grid = 0;
    if (grid == 0) {
        if (n_in != 14 || in_sizes[0] != TOK * DM || out_size != TOK * DM || ws_size < WS_END) {
            fprintf(stderr, "kernel_launch: unexpected shapes (n_in %d, in0 %d, out %d, ws %zu)\n", n_in, n_in > 0 ? in_sizes[0] : -1, out_size, ws_size); grid = -1; return; }
        int dev = 0, cus = 0, per_cu = 0;
        (void)hipGetDevice(&dev); (void)hipDeviceGetAttribute(&cus, hipDeviceAttributeMultiprocessorCount, dev);
        if (hipFuncSetAttribute((const void*)fwd_megakernel, hipFuncAttributeMaxDynamicSharedMemorySize, LDS_BYTES) != hipSuccess) { fprintf(stderr, "kernel_launch: hipFuncSetAttribute failed\n"); grid = -1; return; }
        if (hipOccupancyMaxActiveBlocksPerMultiprocessor(&per_cu, (const void*)fwd_megakernel, 512, LDS_BYTES) != hipSuccess || per_cu < 1) { fprintf(stderr, "kernel_launch: occupancy query gave %d\n", per_cu); per_cu = 1; }
        (void)hipGetLastError();
        grid = cus * per_cu;
    }
    if (grid < 0) return;
    Params p{};
    p.x = (const float*)d_in[0]; p.w_in = (const float*)d_in[1]; p.lq1 = (const float*)d_in[2]; p.lk1 = (const float*)d_in[3]; p.lq2 = (const float*)d_in[4]; p.lk2 = (const float*)d_in[5];
    p.subg = (const float*)d_in[6]; p.w_out = (const float*)d_in[7]; p.ln1g = (const float*)d_in[8]; p.ln1b = (const float*)d_in[9]; p.w_ff1 = (const float*)d_in[10]; p.w_ff2 = (const float*)d_in[11];
    p.ln2g = (const float*)d_in[12]; p.ln2b = (const float*)d_in[13]; p.out = (float*)d_out; p.ws = (unsigned char*)d_ws;
    if (hipMemsetAsync((unsigned char*)d_ws + WS_BAR, 0, XCD_BAR_WORDS * sizeof(unsigned), stream) != hipSuccess) { fprintf(stderr, "kernel_launch: hipMemsetAsync of the barrier words failed\n"); return; }
    void* args[] = {&p};
    hipError_t e = hipLaunchCooperativeKernel((const void*)fwd_megakernel, dim3(grid), dim3(512), args, LDS_BYTES, stream);
    if (e != hipSuccess) fprintf(stderr, "kernel_launch: cooperative launch failed: %s (grid %d)\n", hipGetErrorString(e), grid);
}
```

```cpp
#include <hip/hip_runtime.h>
#include <hip/hip_cooperative_groups.h>
#include <cstdio>
namespace cg = cooperative_groups;
namespace pg8 {
#define PG8_LAS __attribute__((address_space(3)))
typedef unsigned short bf16_t;
typedef short bf16x8 __attribute__((ext_vector_type(8)));
typedef float f32x4 __attribute__((ext_vector_type(4)));
typedef unsigned u32x4 __attribute__((ext_vector_type(4)));
constexpr int BM = 256, BK = 64, HALF = 128, HTB = HALF * BK * 2  , STAGE_BYTES = 8 * HTB, NXCD = 8, WGM = 8;

__host__ __device__ __forceinline__ int lds_byte(int r, int c) { const int st = (r >> 4) * 2 + (c >> 5), rr = r & 15, cc = c & 31, ob = rr * 64 + cc * 2; return st * 1024 + (ob ^ (((ob >> 9) & 1) << 5)); }
__host__ __device__ __forceinline__ void stage_rc(int b, int& R, int& C) { const int st = b / 1024, sb = b % 1024, swz = sb ^ (((sb >> 9) & 1) << 5); R = (st >> 1) * 16 + swz / 64; C = (st & 1) * 32 + (swz % 64) / 2; }
__host__ __device__ __forceinline__ int perm32(int rho) { const int n = rho >> 4, i = rho & 15; return 8 * (i >> 2) + 4 * n + (i & 3); }

struct Unit { int pm, pn; };
struct Gemm { const bf16_t* A; const bf16_t* Bt; int M, N, K; };

struct StaticOrder {
    int nM, nN, nwg, G, c;
    __host__ __device__ void init(int M, int N, int G_, int c_) { nM = M / BM; nN = N / BM; nwg = nM * nN; G = G_; c = c_; }
    __host__ __device__ bool next(int i, Unit& u) const {
        const long L = (long)i * G + c; if (L >= nwg) return false;
        int wgid = (int)L; { const int q = nwg / NXCD, r = nwg % NXCD, xcd = wgid % NXCD, off = wgid / NXCD; wgid = (xcd < r ? xcd * (q + 1) : r * (q + 1) + (xcd - r) * q) + off; }
        const int nig = WGM * nN, gid = wgid / nig, fm = gid * WGM, gsz = (nM - fm) < WGM ? (nM - fm) : WGM;
        u.pm = fm + ((wgid % nig) % gsz); u.pn = (wgid % nig) / gsz; return true;
    }
    __device__ __forceinline__ void a_ready(const Unit&) const {}
    __device__ __forceinline__ void done(const Unit&) const {}
};

typedef int v8i_t __attribute__((ext_vector_type(8)));
typedef int v4i_t __attribute__((ext_vector_type(4)));
__device__ __forceinline__ v8i_t cat8(bf16x8 a, bf16x8 b) { return __builtin_shufflevector(__builtin_bit_cast(v4i_t, a), __builtin_bit_cast(v4i_t, b), 0, 1, 2, 3, 4, 5, 6, 7); }
template <class Epi, class Sched, bool FP8 = false, bool STAMP = false>
__device__ __forceinline__ void gemm_phase(PG8_LAS unsigned char* lds, const Gemm g, const Sched& S, const Epi& E, unsigned long long* stamps) {
    int tid_ = threadIdx.x; asm volatile("" : "+v"(tid_)); const int tid = tid_, wid = __builtin_amdgcn_readfirstlane(tid >> 6), lane = tid & 63, wr = wid >> 2, wc = wid & 3, fr = lane & 15, fq = lane >> 4;
    const int K = g.K, nt = K / BK;
    int ts_lo = 0, ts_hi = 0, nts = 0; const unsigned long long rt_entry = STAMP ? (unsigned long long)wall_clock64() : 0ull;
#define PG8_STAMP() do { if (STAMP && wid == 0 && nts < 64) { const unsigned long long _c = (unsigned long long)clock64(); \
        ts_lo = (lane == nts) ? (int)(unsigned)_c : ts_lo; ts_hi = (lane == nts) ? (int)(unsigned)(_c >> 32) : ts_hi; ++nts; } } while (0)
    PG8_STAMP();
    unsigned voffA[2], voffB[2];
#pragma unroll
    for (int i = 0; i < 2; ++i) { int R, C; stage_rc(tid * 16 + i * 8192, R, C); const int Rb = Epi::PERM ? ((R & ~31) + perm32(R & 31)) : R;
        voffA[i] = (unsigned)(R * K + C) * 2u; voffB[i] = (unsigned)(Rb * K + C) * 2u; }
    const size_t kstep = (size_t)(BK * 2);
    const size_t hstep = (size_t)HALF * K * 2;
    const size_t tstep = 2 * hstep;
    const unsigned ldsw = (unsigned)wid * 1024u;
    const int aoff = lds_byte(wr * 64 + fr, fq * 8), boff = lds_byte(wc * 32 + fr, fq * 8);
#define PG8_SA(b, h) (((b) * 2 + (h)) * HTB)
#define PG8_SB(b, h) ((4 + (b) * 2 + (h)) * HTB)
#define PG8_STAGE(bufoff, gbase, voff) do { _Pragma("unroll") for (int _i = 0; _i < 2; ++_i) \
        __builtin_amdgcn_global_load_lds((const unsigned*)((const char*)(gbase) + (voff)[_i]), (PG8_LAS unsigned*)(lds + (bufoff) + ldsw + _i * 8192), 16, 0, 0); } while (0)
#define PG8_LDA(dst, b, h) do { _Pragma("unroll") for (int m = 0; m < 4; ++m) _Pragma("unroll") for (int k = 0; k < 2; ++k) dst[m][k] = *(const PG8_LAS bf16x8*)(lds + PG8_SA(b, h) + aoff + m * 2048 + k * 1024); } while (0)
#define PG8_LDB(dst, b, h) do { _Pragma("unroll") for (int n = 0; n < 2; ++n) _Pragma("unroll") for (int k = 0; k < 2; ++k) dst[n][k] = *(const PG8_LAS bf16x8*)(lds + PG8_SB(b, h) + boff + n * 2048 + k * 1024); } while (0)
#define PG8_MMA(ai, bj, At, Bt) do { __builtin_amdgcn_s_setprio(1); _Pragma("unroll") for (int m = 0; m < 4; ++m) _Pragma("unroll") for (int n = 0; n < 2; ++n) { \
        if constexpr (FP8) { asm volatile("v_mfma_scale_f32_16x16x128_f8f6f4 %0, %1, %2, %0, %3, %3 op_sel_hi:[0,0,0]" : "+v"(acc[ai][bj][m][n]) : "v"(cat8(Bt[n][0], Bt[n][1])), "v"(cat8(At[m][0], At[m][1])), "v"(f8scale)); } \
        else { _Pragma("unroll") for (int k = 0; k < 2; ++k) acc[ai][bj][m][n] = __builtin_amdgcn_mfma_f32_16x16x32_bf16(Bt[n][k], At[m][k], acc[ai][bj][m][n], 0, 0, 0); } } \
        __builtin_amdgcn_s_setprio(0); } while (0)
#define PG8_WAIT_V(n) asm volatile("s_waitcnt vmcnt(" #n ")" ::: "memory")
#define PG8_WAIT_L(n) asm volatile("s_waitcnt lgkmcnt(" #n ")" ::: "memory")
#define PG8_BAR __builtin_amdgcn_s_barrier()
#define PG8_SCHED __builtin_amdgcn_sched_barrier(0)
    Unit cur, nxt; int ui = 0;
    if (!S.next(0, cur)) return;
    f32x4 acc[2][2][4][2];
#pragma unroll
    for (int a = 0; a < 2; ++a)
#pragma unroll
        for (int b = 0; b < 2; ++b)
#pragma unroll
            for (int m = 0; m < 4; ++m)
#pragma unroll
                for (int n = 0; n < 2; ++n) acc[a][b][m][n] = (f32x4){0.f, 0.f, 0.f, 0.f};
    bf16x8 At[4][2], B0[2][2], B1[2][2];
    const int f8scale = 0x7f7f7f7f;
    const char* cA = (const char*)g.A + (size_t)cur.pm * tstep; const char* cB = (const char*)g.Bt + (size_t)cur.pn * tstep;
    S.a_ready(cur);
    PG8_STAGE(PG8_SB(0, 0), cB, voffB); PG8_STAGE(PG8_SA(0, 0), cA, voffA); PG8_STAGE(PG8_SB(0, 1), cB + hstep, voffB); PG8_STAGE(PG8_SA(0, 1), cA + hstep, voffA);
    if (wr == 1) PG8_BAR;
    PG8_WAIT_V(4); PG8_BAR;
    PG8_STAGE(PG8_SB(1, 0), cB + kstep, voffB); PG8_STAGE(PG8_SA(1, 0), cA + kstep, voffA); PG8_STAGE(PG8_SB(1, 1), cB + hstep + kstep, voffB);
    PG8_WAIT_V(6); PG8_BAR;
    PG8_STAMP();
    for (;;) {
        const bool has_next = S.next(ui + 1, nxt);
        const char* nA = has_next ? (const char*)g.A + (size_t)nxt.pm * tstep : cA; const char* nB = has_next ? (const char*)g.Bt + (size_t)nxt.pn * tstep : cB;
        for (int t = 0; t < nt; t += 2) {
            const bool last = (t == nt - 2);
            const char* a1 = cA + (size_t)(t + 1) * kstep;
            const char* a2 = last ? nA : cA + (size_t)(t + 2) * kstep; const char* b2 = last ? nB : cB + (size_t)(t + 2) * kstep;
            const char* a3 = a2 + kstep; const char* b3 = b2 + kstep;
            if (last && has_next) S.a_ready(nxt);
            PG8_LDB(B0, 0, 0); PG8_SCHED; PG8_LDA(At, 0, 0); PG8_STAGE(PG8_SA(1, 1), a1 + hstep, voffA);
            PG8_WAIT_L(8); PG8_BAR; PG8_WAIT_L(0); PG8_MMA(0, 0, At, B0); PG8_BAR; PG8_SCHED;
            PG8_LDB(B1, 0, 1); PG8_STAGE(PG8_SB(0, 0), b2, voffB);
            PG8_BAR; PG8_WAIT_L(0); PG8_MMA(0, 1, At, B1); PG8_BAR;
            PG8_LDA(At, 0, 1); PG8_STAGE(PG8_SA(0, 0), a2, voffA);
            PG8_BAR; PG8_WAIT_L(0); PG8_MMA(1, 0, At, B0); PG8_BAR; PG8_SCHED;
            PG8_STAGE(PG8_SB(0, 1), b2 + hstep, voffB);
            PG8_WAIT_V(6); PG8_BAR; PG8_MMA(1, 1, At, B1); PG8_BAR;
            PG8_LDB(B0, 1, 0); PG8_SCHED; PG8_LDA(At, 1, 0); PG8_STAGE(PG8_SA(0, 1), a2 + hstep, voffA);
            PG8_WAIT_L(8); PG8_BAR; PG8_WAIT_L(0); PG8_MMA(0, 0, At, B0); PG8_BAR; PG8_SCHED;
            PG8_LDB(B1, 1, 1); PG8_STAGE(PG8_SB(1, 0), b3, voffB);
            PG8_BAR; PG8_WAIT_L(0); PG8_MMA(0, 1, At, B1); PG8_BAR;
            PG8_LDA(At, 1, 1); PG8_STAGE(PG8_SA(1, 0), a3, voffA);
            PG8_BAR; PG8_WAIT_L(0); PG8_MMA(1, 0, At, B0); PG8_BAR; PG8_SCHED;
            PG8_STAGE(PG8_SB(1, 1), b3 + hstep, voffB);
            PG8_WAIT_V(6); PG8_BAR; PG8_MMA(1, 1, At, B1); PG8_BAR;
        }
        PG8_STAMP();
        if constexpr (FP8) { asm volatile("s_nop 15\n\ts_nop 15" ::: "memory"); }
        if constexpr (!Epi::AFTER_DRAIN) { E(acc, cur, wr, wc, fr, fq); S.done(cur); }
        PG8_STAMP();
        if (!has_next) break;
#pragma unroll
        for (int a = 0; a < 2; ++a)
#pragma unroll
            for (int b = 0; b < 2; ++b)
#pragma unroll
                for (int m = 0; m < 4; ++m)
#pragma unroll
                    for (int n = 0; n < 2; ++n) acc[a][b][m][n] = (f32x4){0.f, 0.f, 0.f, 0.f};
        cur = nxt; cA = nA; cB = nB; ++ui;
    }
    PG8_WAIT_V(0);
    if (wr == 0) PG8_BAR;
    PG8_BAR;
    if constexpr (Epi::AFTER_DRAIN) { E.fused(acc, cur, wr, wc, fr, fq, lds, wid, lane); S.done(cur); }
    PG8_STAMP();
    if (STAMP && wid == 0) { stamps[lane] = lane < nts ? (((unsigned long long)(unsigned)ts_hi << 32) | (unsigned)ts_lo) : 0ull;
        if (lane == 62) stamps[62] = rt_entry; if (lane == 63) stamps[63] = (unsigned long long)wall_clock64(); }
#undef PG8_STAMP
#undef PG8_SA
#undef PG8_SB
#undef PG8_STAGE
#undef PG8_LDA
#undef PG8_LDB
#undef PG8_MMA
#undef PG8_WAIT_V
#undef PG8_WAIT_L
#undef PG8_BAR
#undef PG8_SCHED
}
}
#define LAS __attribute__((address_space(3)))

#define XB_TMO      128
#define XB_XCNT(j)  (256  + 64 * (j))
#define XB_XSUB(j)  (1280 + 64 * (j))
#define XB_XGEN(j)  (2304 + 64 * (j))
#define XB_TOP      3328
#define XB_TOPGEN   3392
#define XCD_BAR_WORDS 3456
#define XB_SPIN_CAP (1u << 22)

__device__ __forceinline__ unsigned xb_ld(unsigned* p)              { return __hip_atomic_load(p, __ATOMIC_RELAXED, __HIP_MEMORY_SCOPE_AGENT); }
__device__ __forceinline__ unsigned xb_add(unsigned* p, unsigned v) { return __hip_atomic_fetch_add(p, v, __ATOMIC_RELAXED, __HIP_MEMORY_SCOPE_AGENT); }
__device__ __forceinline__ unsigned xb_xcc_id() { return (unsigned)__builtin_amdgcn_s_getreg((3 << 11) | 20) & 0xFu; }
#define XB_SPIN(cond, bar) do { unsigned _sp = 0; while (cond) { __builtin_amdgcn_s_sleep(1); \
    if ((++_sp & 255u) == 0u) { if (xb_ld(&(bar)[XB_TMO])) break; if (_sp > XB_SPIN_CAP) { atomicAdd(&(bar)[XB_TMO], 1u); break; } } } } while (0)

struct XcdBarrier {
    unsigned* bar; unsigned x;
    volatile LAS unsigned* st;
};

__device__ __forceinline__ XcdBarrier xcd_barrier_post(unsigned* bar, volatile LAS unsigned* st) {
    XcdBarrier b; b.bar = bar; b.x = xb_xcc_id(); b.st = st;
    if (threadIdx.x == 0) (void)xb_add(&bar[XB_XCNT(b.x)], 1u);
    return b;
}
__device__ __forceinline__ void xcd_barrier_complete(unsigned* bar, unsigned x, unsigned& nloc, unsigned& nx) {
    const unsigned G = gridDim.x * gridDim.y * gridDim.z;
    unsigned sum, cnt, mine, sp = 0u;
    for (;;) {
        sum = 0u; cnt = 0u; mine = 0u;
#pragma unroll
        for (unsigned j = 0; j < 16; ++j) { const unsigned c = xb_ld(&bar[XB_XCNT(j)]); sum += c; cnt += (c > 0u) ? 1u : 0u; mine = (j == x) ? c : mine; }
        if (sum == G) break;
        __builtin_amdgcn_s_sleep(1);
        if ((++sp & 255u) == 0u) { if (xb_ld(&bar[XB_TMO])) break; if (sp > XB_SPIN_CAP) { atomicAdd(&bar[XB_TMO], 1u); break; } }
    }
    nloc = mine > 0u ? mine : 1u; nx = cnt > 0u ? cnt : 1u;
}

__device__ __forceinline__ void xcd_barrier(const XcdBarrier& b) {
    asm volatile("s_waitcnt vmcnt(0)" ::: "memory");
    __syncthreads();
    if (threadIdx.x == 0) {
        unsigned* bar = b.bar;
        __builtin_amdgcn_s_waitcnt(0);
        unsigned nloc = b.st[0], nx = b.st[1];
        if (nloc == 0u) { xcd_barrier_complete(bar, b.x, nloc, nx); b.st[0] = nloc; b.st[1] = nx; }
        const unsigned old = xb_add(&bar[XB_XSUB(b.x)], 1u);
        const unsigned gen = old / nloc;
        if (old + 1u == (gen + 1u) * nloc) {
            __builtin_amdgcn_fence(__ATOMIC_RELEASE, "agent");
            asm volatile("s_waitcnt vmcnt(0)" ::: "memory");
            const unsigned og = xb_add(&bar[XB_TOP], 1u);
            const unsigned tg = og / nx;
            if (og + 1u == (tg + 1u) * nx) xb_add(&bar[XB_TOPGEN], 1u);
            else XB_SPIN(xb_ld(&bar[XB_TOPGEN]) == tg, bar);
            __builtin_amdgcn_fence(__ATOMIC_ACQUIRE, "agent");
            xb_add(&bar[XB_XGEN(b.x)], 1u);
            asm volatile("s_waitcnt vmcnt(0)" ::: "memory");
        } else {
            XB_SPIN(xb_ld(&bar[XB_XGEN(b.x)]) == gen, bar);
            __builtin_amdgcn_fence(__ATOMIC_ACQUIRE, "agent");
            asm volatile("s_waitcnt vmcnt(0)" ::: "memory");
        }
    }
    __syncthreads();
}


using pg8::bf16_t; using pg8::bf16x8; using pg8::f32x4; using pg8::u32x4; using pg8::Unit;
#define DI __device__ __forceinline__
DI int opaque_tid() { int t = threadIdx.x; asm volatile("" : "+v"(t)); return t; }
typedef float f32x16 __attribute__((ext_vector_type(16)));
typedef short s16x4 __attribute__((ext_vector_type(4)));
typedef float f32x2 __attribute__((ext_vector_type(2)));
typedef unsigned u32x2 __attribute__((ext_vector_type(2)));
typedef __bf16 bf2_t __attribute__((ext_vector_type(2)));

constexpr int TOK = 32768, DM = 2048, SEQ = 2048, DFF = 8192;
constexpr size_t MiB = (size_t)1 << 20;
constexpr size_t WS_WQK = 0, WS_WV = 16 * MiB, WS_WOUT = 24 * MiB, WS_WFF1 = 32 * MiB, WS_WFF2 = 64 * MiB, WS_TABA = 96 * MiB, WS_TABB = 96 * MiB + 512 * 1024,
                 WS_STATS = 97 * MiB + 512 * 1024, WS_BAR = 97 * MiB + 768 * 1024, WS_X1B = 98 * MiB, WS_XB = 226 * MiB, WS_QK = 354 * MiB, WS_VT = 610 * MiB, WS_HDN = 226 * MiB, WS_END = 738 * MiB;
constexpr int LDS_BYTES = 131072;
constexpr int REP_P0 = 1, REP_P1 = 1, REP_ATT = 1, REP_P3 = 1, REP_LN1 = 1, REP_P5 = 1;
constexpr float DN_ALPHA = 1.189207115002721f;

DI unsigned pk_bf16(float lo, float hi) { f32x2 v = {lo, hi}; bf2_t b = __builtin_convertvector(v, bf2_t); return __builtin_bit_cast(unsigned, b); }
DI float bf_lo(unsigned w) { return __uint_as_float(w << 16); }
DI float bf_hi(unsigned w) { return __uint_as_float(w & 0xffff0000u); }
DI float xhalf_max(float v) { auto r = __builtin_amdgcn_permlane32_swap(__float_as_uint(v), __float_as_uint(v), false, false); return fmaxf(__uint_as_float(r[0]), __uint_as_float(r[1])); }
DI float xhalf_sum(float v) { auto r = __builtin_amdgcn_permlane32_swap(__float_as_uint(v), __float_as_uint(v), false, false); return __uint_as_float(r[0]) + __uint_as_float(r[1]); }
#define MFMA32(a, b, c) __builtin_amdgcn_mfma_f32_32x32x16_bf16((a), (b), (c), 0, 0, 0)

struct Params {
    const float* x; const float* w_in; const float* lq1; const float* lk1; const float* lq2; const float* lk2; const float* subg; const float* w_out;
    const float* ln1g; const float* ln1b; const float* w_ff1; const float* w_ff2; const float* ln2g; const float* ln2b; float* out; unsigned char* ws;
};

struct EpiRope {
    static constexpr bool PERM = true, AFTER_DRAIN = false;
    bf16_t* QK; const float* tabA; const float* tabB;
    DI void operator()(const f32x4 (&acc)[2][2][4][2], const Unit& u, int, int, int, int) const {
        const int t_ = opaque_tid(), wid_ = __builtin_amdgcn_readfirstlane(t_ >> 6), wr = wid_ >> 2, wc = wid_ & 3, fr = t_ & 15, fq = (t_ & 63) >> 4;
        const bool dil = (u.pn >> 2) >= 2;
        const int half = dil ? 64 : 32;
        const int lc0 = dil ? (128 * (wc >> 1) + 32 * (wc & 1) + 8 * fq) : (64 * wc + 8 * fq);
        const int ri0 = dil ? (32 * (wc & 1) + 8 * fq) : (8 * fq);
        const float* tab = dil ? tabB : tabA;
        const int row0 = u.pm * 256 + wr * 64 + fr;
        const int region = u.pn >> 2;
        const float osc = region == 0 ? 0.125f * 1.4426950408889634f : (region == 2 ? 0.08838834764831845f * 1.4426950408889634f : 1.0f);
        f32x4 tt[2][4];
        {
            const f32x4* tp = (const f32x4*)(tab + ((size_t)(row0 & (SEQ - 1)) * half + ri0) * 2);
            tt[0][0] = tp[0]; tt[0][1] = tp[1]; tt[0][2] = tp[2]; tt[0][3] = tp[3];
        }
#pragma unroll
        for (int it = 0; it < 8; ++it) {
            const int ai = it >> 2, m = it & 3;
            const int row = row0 + ai * 128 + m * 16;
            if (it + 1 < 8) {
                const int nrow = row0 + ((it + 1) >> 2) * 128 + ((it + 1) & 3) * 16;
                const f32x4* tp = (const f32x4*)(tab + ((size_t)(nrow & (SEQ - 1)) * half + ri0) * 2);
                tt[(it + 1) & 1][0] = tp[0]; tt[(it + 1) & 1][1] = tp[1]; tt[(it + 1) & 1][2] = tp[2]; tt[(it + 1) & 1][3] = tp[3];
            }
            float lo[8], hi[8];
#pragma unroll
            for (int n = 0; n < 2; ++n)
#pragma unroll
                for (int j = 0; j < 4; ++j) {
                    const int idx = 4 * n + j; const float c = tt[it & 1][idx >> 1][(idx & 1) * 2], s = tt[it & 1][idx >> 1][(idx & 1) * 2 + 1];
                    const float x0 = acc[ai][0][m][n][j], x1 = acc[ai][1][m][n][j];
                    lo[idx] = (x0 * c - x1 * s) * osc; hi[idx] = (x1 * c + x0 * s) * osc;
                }
            bf16_t* rp = QK + (size_t)row * 4096 + u.pn * 256 + lc0;
            u32x4 w0, w1;
            w0.x = pk_bf16(lo[0], lo[1]); w0.y = pk_bf16(lo[2], lo[3]); w0.z = pk_bf16(lo[4], lo[5]); w0.w = pk_bf16(lo[6], lo[7]);
            w1.x = pk_bf16(hi[0], hi[1]); w1.y = pk_bf16(hi[2], hi[3]); w1.z = pk_bf16(hi[4], hi[5]); w1.w = pk_bf16(hi[6], hi[7]);
            *(u32x4*)rp = w0; *(u32x4*)(rp + half) = w1;
        }
    }
};
template <int ACT  > struct EpiBf {
    static constexpr bool PERM = true, AFTER_DRAIN = false;
    bf16_t* O; int ldc;
    DI void operator()(const f32x4 (&acc)[2][2][4][2], const Unit& u, int, int, int, int) const {
        const int t_ = opaque_tid(), wid_ = __builtin_amdgcn_readfirstlane(t_ >> 6), wr = wid_ >> 2, wc = wid_ & 3, fr = t_ & 15, fq = (t_ & 63) >> 4;
        const int row0 = u.pm * 256 + wr * 64 + fr, col0 = u.pn * 256 + wc * 32 + 8 * fq;
#pragma unroll
        for (int ai = 0; ai < 2; ++ai)
#pragma unroll
            for (int m = 0; m < 4; ++m) {
                bf16_t* rowp = O + (size_t)(row0 + ai * 128 + m * 16) * ldc + col0;
#pragma unroll
                for (int bj = 0; bj < 2; ++bj) {
                    f32x4 v0 = acc[ai][bj][m][0], v1 = acc[ai][bj][m][1];
                    if (ACT == 1) {
#pragma unroll
                        for (int j = 0; j < 4; ++j) { const float a = fmaxf(v0[j], 0.f), b = fmaxf(v1[j], 0.f); v0[j] = a * a; v1[j] = b * b; }
                    }
                    u32x4 w; w.x = pk_bf16(v0[0], v0[1]); w.y = pk_bf16(v0[2], v0[3]); w.z = pk_bf16(v1[0], v1[1]); w.w = pk_bf16(v1[2], v1[3]);
                    *(u32x4*)(rowp + bj * 128) = w;
                }
            }
    }
};
struct EpiRes {
    static constexpr bool PERM = false, AFTER_DRAIN = false;
    const float* R; float* C; float scale;
    DI void operator()(const f32x4 (&acc)[2][2][4][2], const Unit& u, int, int, int, int) const {
        const int t_ = opaque_tid(), wid_ = __builtin_amdgcn_readfirstlane(t_ >> 6), wr = wid_ >> 2, wc = wid_ & 3, fr = t_ & 15, fq = (t_ & 63) >> 4;
        const int row0 = u.pm * 256 + wr * 64 + fr, col0 = u.pn * 256 + wc * 32 + 4 * fq;
#pragma unroll
        for (int ai = 0; ai < 2; ++ai)
#pragma unroll
            for (int m = 0; m < 4; ++m) {
                const size_t off = (size_t)(row0 + ai * 128 + m * 16) * DM + col0;
#pragma unroll
                for (int bj = 0; bj < 2; ++bj)
#pragma unroll
                    for (int n = 0; n < 2; ++n) {
                        const f32x4 rv = *(const f32x4*)(R + off + bj * 128 + n * 16);
                        *(f32x4*)(C + off + bj * 128 + n * 16) = rv * DN_ALPHA + acc[ai][bj][m][n] * scale;
                    }
            }
    }
};

struct EpiResBf {
    static constexpr bool PERM = true, AFTER_DRAIN = false;
    const float* R; bf16_t* Y;
    DI void operator()(const f32x4 (&acc)[2][2][4][2], const Unit& u, int, int, int, int) const {
        const int t_ = opaque_tid(), wid_ = __builtin_amdgcn_readfirstlane(t_ >> 6), wr = wid_ >> 2, wc = wid_ & 3, fr = t_ & 15, fq = (t_ & 63) >> 4;
        const int row0 = u.pm * 256 + wr * 64 + fr, col0 = u.pn * 256 + wc * 32 + 8 * fq;
#pragma unroll
        for (int ai = 0; ai < 2; ++ai)
#pragma unroll
            for (int m = 0; m < 4; ++m) {
                const size_t off = (size_t)(row0 + ai * 128 + m * 16) * DM + col0;
#pragma unroll
                for (int bj = 0; bj < 2; ++bj) {
                    const f32x4 r0 = __builtin_nontemporal_load((const f32x4*)(R + off + bj * 128)), r1 = __builtin_nontemporal_load((const f32x4*)(R + off + bj * 128 + 4));
                    const f32x4 v0 = r0 * DN_ALPHA + acc[ai][bj][m][0], v1 = r1 * DN_ALPHA + acc[ai][bj][m][1];
                    u32x4 w; w.x = pk_bf16(v0[0], v0[1]); w.y = pk_bf16(v0[2], v0[3]); w.z = pk_bf16(v1[0], v1[1]); w.w = pk_bf16(v1[2], v1[3]);
                    *(u32x4*)(Y + off + bj * 128) = w;
                }
            }
    }
};
struct EpiResLnBf {
    static constexpr bool PERM = true, AFTER_DRAIN = false;
    const bf16_t* Y1; const float* stats; const float* g; const float* b; bf16_t* Y;
    DI void operator()(const f32x4 (&acc)[2][2][4][2], const Unit& u, int, int, int, int) const {
        const int t_ = opaque_tid(), wid_ = __builtin_amdgcn_readfirstlane(t_ >> 6), wr = wid_ >> 2, wc = wid_ & 3, fr = t_ & 15, fq = (t_ & 63) >> 4;
        const int row0 = u.pm * 256 + wr * 64 + fr, col0 = u.pn * 256 + wc * 32 + 8 * fq;
        f32x4 gg[2][2], bb[2][2];
#pragma unroll
        for (int bj = 0; bj < 2; ++bj)
#pragma unroll
            for (int n = 0; n < 2; ++n) { gg[bj][n] = *(const f32x4*)(g + col0 + bj * 128 + 4 * n); bb[bj][n] = *(const f32x4*)(b + col0 + bj * 128 + 4 * n); }
#pragma unroll
        for (int ai = 0; ai < 2; ++ai)
#pragma unroll
            for (int m = 0; m < 4; ++m) {
                const int row = row0 + ai * 128 + m * 16;
                const size_t off = (size_t)row * DM + col0;
                const f32x2 st = *(const f32x2*)(stats + 2 * row);
#pragma unroll
                for (int bj = 0; bj < 2; ++bj) {
                    const u32x4 yw = __builtin_nontemporal_load((const u32x4*)(Y1 + off + bj * 128));
                    f32x4 v0, v1;
#pragma unroll
                    for (int j = 0; j < 2; ++j) {
                        v0[2 * j] = (bf_lo(yw[j]) - st[0]) * st[1] * gg[bj][0][2 * j] + bb[bj][0][2 * j];
                        v0[2 * j + 1] = (bf_hi(yw[j]) - st[0]) * st[1] * gg[bj][0][2 * j + 1] + bb[bj][0][2 * j + 1];
                        v1[2 * j] = (bf_lo(yw[2 + j]) - st[0]) * st[1] * gg[bj][1][2 * j] + bb[bj][1][2 * j];
                        v1[2 * j + 1] = (bf_hi(yw[2 + j]) - st[0]) * st[1] * gg[bj][1][2 * j + 1] + bb[bj][1][2 * j + 1];
                    }
                    v0 = v0 * DN_ALPHA + acc[ai][bj][m][0]; v1 = v1 * DN_ALPHA + acc[ai][bj][m][1];
                    u32x4 w; w.x = pk_bf16(v0[0], v0[1]); w.y = pk_bf16(v0[2], v0[3]); w.z = pk_bf16(v1[0], v1[1]); w.w = pk_bf16(v1[2], v1[3]);
                    *(u32x4*)(Y + off + bj * 128) = w;
                }
            }
    }
};

DI void tconv_tile(LAS unsigned char* lds, const float* src, int N, int K, bf16_t* dst, int p0, int c0, int k0) {
    const int tid = opaque_tid();
    LAS bf16_t* tile = (LAS bf16_t*)lds;
#pragma unroll
    for (int i = 0; i < 4; ++i) {
        const int u = tid + 512 * i, kl = u >> 3, c4 = (u & 7) * 4;
        const f32x4 v = __builtin_nontemporal_load((const f32x4*)(src + (size_t)(k0 + kl) * N + c0 + c4));
        const unsigned w0 = pk_bf16(v[0], v[1]), w1 = pk_bf16(v[2], v[3]);
        tile[(c4 + 0) * 264 + kl] = (bf16_t)(w0 & 0xffffu); tile[(c4 + 1) * 264 + kl] = (bf16_t)(w0 >> 16);
        tile[(c4 + 2) * 264 + kl] = (bf16_t)(w1 & 0xffffu); tile[(c4 + 3) * 264 + kl] = (bf16_t)(w1 >> 16);
    }
    __syncthreads();
#pragma unroll
    for (int i = 0; i < 2; ++i) {
        const int ch = tid + 512 * i, pr = ch >> 5, kc = (ch & 31) * 8;
        const u32x4 w = *(const LAS u32x4*)(lds + pr * 528 + kc * 2);
        *(u32x4*)(dst + (size_t)(p0 + pr) * K + k0 + kc) = w;
    }
    __syncthreads();
}
DI void sincos_d(double r, float& s, float& c) {
    const double r2 = r * r;
    double ts = 1.0, tc = 1.0, ss = 1.0, cs = 1.0;
#pragma unroll
    for (int n = 1; n <= 13; ++n) { tc = -tc * r2 * (1.0 / (double)((2 * n - 1) * (2 * n))); ts = -ts * r2 * (1.0 / (double)((2 * n) * (2 * n + 1))); cs += tc; ss += ts; }
    s = (float)(r * ss); c = (float)cs;
}
DI void p0_phase(LAS unsigned char* lds, const Params& p) {
    const int G = gridDim.x, bid = blockIdx.x, tid = opaque_tid();
    const size_t gtid = (size_t)bid * 512 + tid, gth = (size_t)G * 512;
    unsigned char* ws = p.ws;
    {
        const f32x4* xs = (const f32x4*)p.x; u32x4* xd = (u32x4*)(ws + WS_XB);
        constexpr size_t NV = (size_t)TOK * DM / 8;
        for (size_t i0 = gtid; i0 < NV; i0 += 4 * gth) {
            f32x4 a[4], b[4];
#pragma unroll
            for (int u = 0; u < 4; ++u) { const size_t i = i0 + u * gth; if (i < NV) { a[u] = __builtin_nontemporal_load(xs + 2 * i); b[u] = __builtin_nontemporal_load(xs + 2 * i + 1); } }
#pragma unroll
            for (int u = 0; u < 4; ++u) { const size_t i = i0 + u * gth; if (i < NV) { u32x4 w;
                w.x = pk_bf16(a[u][0], a[u][1]); w.y = pk_bf16(a[u][2], a[u][3]); w.z = pk_bf16(b[u][0], b[u][1]); w.w = pk_bf16(b[u][2], b[u][3]); xd[i] = w; } }
        }
    }
    {
        float* tabA = (float*)(ws + WS_TABA); float* tabB = (float*)(ws + WS_TABB);
        for (size_t idx = gtid; idx < (size_t)SEQ * 96; idx += gth) {
            const int pos = (int)(idx / 96), j = (int)(idx % 96);
            const bool dil = j >= 32; const int i = dil ? j - 32 : j;
            const float ex = dil ? (float)(2 * i) / 128.0f : (float)(2 * i) / 64.0f;
            const float inv = 1.0f / powf(10000.0f, ex);
            const float ang = (float)pos * inv;
            const double a = (double)ang; const double kk = rint(a * 0.15915494309189535);
            const double rr = a - kk * 6.283185307179586;
            float s, c; sincos_d(rr, s, c);
            float* d = dil ? tabB + ((size_t)pos * 64 + i) * 2 : tabA + ((size_t)pos * 32 + i) * 2;
            d[0] = c; d[1] = s;
        }
    }
    for (int t = bid; t < 6144; t += G) {
        const float* src; bf16_t* dst; int N, K, p0, c0, k0;
        if (t < 1024) {
            src = p.w_in; dst = (bf16_t*)(ws + WS_WQK); N = 6144; K = 2048; p0 = (t >> 3) * 32; k0 = (t & 7) * 256;
            const int pn = p0 >> 8, pp = p0 & 255, bj = pp >> 7, wc = (pp >> 5) & 3;
            const int lc = (pn >> 2) < 2 ? (64 * wc + 32 * bj) : (128 * (wc >> 1) + 64 * bj + 32 * (wc & 1));
            const int l = pn * 256 + lc; c0 = l < 2048 ? l : l + 1024;
        } else if (t < 1536) {
            const int tt = t - 1024; src = p.w_in; dst = (bf16_t*)(ws + WS_WV); N = 6144; K = 2048; p0 = (tt >> 3) * 32; k0 = (tt & 7) * 256;
            c0 = p0 < 1024 ? 2048 + p0 : 4096 + p0;
        } else if (t < 2048) {
            const int tt = t - 1536; src = p.w_out; dst = (bf16_t*)(ws + WS_WOUT); N = 2048; K = 2048; p0 = (tt >> 3) * 32; k0 = (tt & 7) * 256; c0 = p0;
        } else if (t < 4096) {
            const int tt = t - 2048; src = p.w_ff1; dst = (bf16_t*)(ws + WS_WFF1); N = 8192; K = 2048; p0 = (tt >> 3) * 32; k0 = (tt & 7) * 256; c0 = p0;
        } else {
            const int tt = t - 4096; src = p.w_ff2; dst = (bf16_t*)(ws + WS_WFF2); N = 2048; K = 8192; p0 = (tt >> 5) * 32; k0 = (tt & 31) * 256; c0 = p0;
        }
        tconv_tile(lds, src, N, K, dst, p0, c0, k0);
    }
}

constexpr int A_KP = 272, A_VP = 144, A_KB = 64 * A_KP, A_VB = 128 * A_VP, A_BUF = A_KB + A_VB, A_TBL = 2 * A_BUF, A_TBL_N = 2176;
constexpr float LOG2E = 1.4426950408889634f;

struct AItem { const bf16_t* Qb; const bf16_t* Kb; const bf16_t* VTb; bf16_t* Mb; int qb, type; };
DI void attn_preload(const AItem& it, bf16x8 (&qa)[4], bf16x8 (&qb4)[4], u32x4 (&kr)[2], u32x4 (&vr)[2]) {
    const int tid = opaque_tid(), lane = tid & 63, w = __builtin_amdgcn_readfirstlane(tid >> 6), r = lane & 31, h = lane >> 5;
    const bf16_t* qrow = it.Qb + (size_t)(it.qb * 256 + w * 32 + r) * 4096 + h * 8;
#pragma unroll
    for (int ks = 0; ks < 4; ++ks) { qa[ks] = __builtin_nontemporal_load((const bf16x8*)(qrow + ks * 16)); qb4[ks] = __builtin_nontemporal_load((const bf16x8*)(qrow + 64 + ks * 16)); }
    const int k_row0 = tid >> 4, k_c = tid & 15, v_row0 = tid >> 3, v_c = tid & 7;
#pragma unroll
    for (int i = 0; i < 2; ++i) {
        kr[i] = *(const u32x4*)(it.Kb + (size_t)(k_row0 + i * 32) * 4096 + k_c * 8);
        vr[i] = *(const u32x4*)(it.VTb + (size_t)(v_row0 + i * 64) * 32768 + v_c * 8);
    }
}
#define QF(i_) ((i_) < 4 ? qa[(i_) & 3] : qb4[(i_) & 3])
template <bool DIL>
DI void attn_item(LAS unsigned char* lds, const bf16_t* Qb, const bf16_t* Kb, const bf16_t* VTb, bf16_t* Mb, int qb, float lam, const float* subg,
                  bf16x8 (&qa)[4], bf16x8 (&qb4)[4], u32x4 (&kr)[2], u32x4 (&vr)[2], bool has_next, const AItem& nxt) {
    const int tid = opaque_tid(), lane = tid & 63, w = __builtin_amdgcn_readfirstlane(tid >> 6), r = lane & 31, h = lane >> 5;
    const int q0w = qb * 256 + w * 32;
    const int nt = 4 * qb + 4;
    const int k_row0 = tid >> 4, k_c = tid & 15, v_row0 = tid >> 3, v_c = tid & 7;
    const bf16_t* kg = Kb + (size_t)k_row0 * 4096 + k_c * 8;
    const bf16_t* vg = VTb + (size_t)v_row0 * 32768 + v_c * 8;
    const unsigned k_l = k_row0 * A_KP + k_c * 16, v_l = A_KB + v_row0 * A_VP + (v_c >> 1) * 32 + (v_c & 1) * 8;
    const unsigned ka_off = r * A_KP + h * 16, va_off = A_KB + r * A_VP + h * 16;
    constexpr int NPASS = DIL ? 1 : 2, NKS = DIL ? 8 : 4;
#pragma unroll
    for (int pass = 0; pass < NPASS; ++pass) {
        f32x16 oacc[4];
#pragma unroll
        for (int db = 0; db < 4; ++db)
#pragma unroll
            for (int i = 0; i < 16; ++i) oacc[db][i] = 0.f;
        float m_run = 0.f, l_run = 0.f;
#define A_LOAD(kt) do { _Pragma("unroll") for (int i_ = 0; i_ < 2; ++i_) { \
            kr[i_] = *(const u32x4*)(kg + (size_t)((kt) * 64 + i_ * 32) * 4096); \
            vr[i_] = *(const u32x4*)(vg + (size_t)(i_ * 64) * 32768 + (kt) * 64); } } while (0)
#define A_STORE(buf) do { LAS unsigned char* b_ = lds + (buf) * A_BUF; _Pragma("unroll") for (int i_ = 0; i_ < 2; ++i_) { \
            *(LAS u32x4*)(b_ + k_l + i_ * 32 * A_KP) = kr[i_]; \
            u32x2 lo_ = {vr[i_].x, vr[i_].y}, hi_ = {vr[i_].z, vr[i_].w}; \
            *(LAS u32x2*)(b_ + v_l + i_ * 64 * A_VP) = lo_; *(LAS u32x2*)(b_ + v_l + i_ * 64 * A_VP + 16) = hi_; } } while (0)
        A_STORE(0); __syncthreads();
        for (int kt = 0; kt < nt; ++kt) {
            const int cur = kt & 1;
            if (kt + 1 < nt) A_LOAD(kt + 1);
            if (kt * 64 <= q0w + 31) {
                LAS unsigned char* bp = lds + cur * A_BUF;
                f32x16 s0, s1;
                const float sinit = -m_run;
#pragma unroll
                for (int i = 0; i < 16; ++i) { s0[i] = sinit; s1[i] = sinit; }
                {
                    bf16x8 kf[2][4];
#define A_LDK(g_, d_) do { _Pragma("unroll") for (int q_ = 0; q_ < 4; ++q_) d_[q_] = *(const LAS bf16x8*)(bp + ka_off + (q_ & 1) * 32 * A_KP + pass * 128 + (2 * (g_) + (q_ >> 1)) * 32); } while (0)
                    A_LDK(0, kf[0]);
                    __builtin_amdgcn_s_setprio(1);
#pragma unroll
                    for (int g = 0; g < NKS / 2; ++g) {
                        if (g + 1 < NKS / 2) A_LDK(g + 1, kf[(g + 1) & 1]);
                        __builtin_amdgcn_sched_barrier(0);
                        s0 = MFMA32(kf[g & 1][0], QF(2 * g), s0); s1 = MFMA32(kf[g & 1][1], QF(2 * g), s1);
                        s0 = MFMA32(kf[g & 1][2], QF(2 * g + 1), s0); s1 = MFMA32(kf[g & 1][3], QF(2 * g + 1), s1);
                        __builtin_amdgcn_sched_barrier(0);
                    }
#undef A_LDK
                    __builtin_amdgcn_s_setprio(0);
                }
                const int base = q0w + r - 4 * h - kt * 64;
                float mx = -1e30f;
                if (DIL) {
                    const LAS float* tb = (const LAS float*)(lds + A_TBL) + (base + 65);
#pragma unroll
                    for (int kb = 0; kb < 2; ++kb)
#pragma unroll
                        for (int i = 0; i < 16; ++i) {
                            const float bias = tb[63 - (32 * kb + (i & 3) + 8 * (i >> 2))];
                            const float t = (kb ? s1[i] : s0[i]) + bias;
                            if (kb) s1[i] = t; else s0[i] = t;
                            mx = fmaxf(mx, t);
                        }
                } else if (kt * 64 + 63 > q0w) {
#pragma unroll
                    for (int kb = 0; kb < 2; ++kb)
#pragma unroll
                        for (int i = 0; i < 16; ++i) {
                            const int dlt = base - (32 * kb + (i & 3) + 8 * (i >> 2));
                            const float t = dlt >= 0 ? (kb ? s1[i] : s0[i]) : -1e30f;
                            if (kb) s1[i] = t; else s0[i] = t;
                            mx = fmaxf(mx, t);
                        }
                } else {
#pragma unroll
                    for (int i = 0; i < 16; ++i) mx = fmaxf(mx, fmaxf(s0[i], s1[i]));
                }
                mx = xhalf_max(mx);
                if (kt == 0 || __any(mx > 8.0f)) {
                    const float delta = kt == 0 ? mx : fmaxf(mx, 0.f);
                    m_run += delta;
                    if (kt != 0) {
                        const float alpha = __builtin_amdgcn_exp2f(-delta);
                        l_run *= alpha;
#pragma unroll
                        for (int db = 0; db < 4; ++db)
#pragma unroll
                            for (int i = 0; i < 16; ++i) oacc[db][i] *= alpha;
                    }
#pragma unroll
                    for (int i = 0; i < 16; ++i) { s0[i] -= delta; s1[i] -= delta; }
                }
                float ls = 0.f, ls2 = 0.f;
#pragma unroll
                for (int i = 0; i < 16; ++i) { const float p0 = __builtin_amdgcn_exp2f(s0[i]), p1 = __builtin_amdgcn_exp2f(s1[i]); s0[i] = p0; s1[i] = p1; ls += p0; asm volatile("" : "+v"(ls)); ls2 += p1; asm volatile("" : "+v"(ls2)); }
                l_run += ls + ls2;
                {
                    u32x4 pw[4];
#pragma unroll
                    for (int s = 0; s < 2; ++s) {
                        pw[s].x = pk_bf16(s0[8 * s + 0], s0[8 * s + 1]); pw[s].y = pk_bf16(s0[8 * s + 2], s0[8 * s + 3]); pw[s].z = pk_bf16(s0[8 * s + 4], s0[8 * s + 5]); pw[s].w = pk_bf16(s0[8 * s + 6], s0[8 * s + 7]);
                        pw[2 + s].x = pk_bf16(s1[8 * s + 0], s1[8 * s + 1]); pw[2 + s].y = pk_bf16(s1[8 * s + 2], s1[8 * s + 3]); pw[2 + s].z = pk_bf16(s1[8 * s + 4], s1[8 * s + 5]); pw[2 + s].w = pk_bf16(s1[8 * s + 6], s1[8 * s + 7]);
                    }
                    bf16x8 vf[2][4];
#define A_LDV(g_, d_) do { _Pragma("unroll") for (int db = 0; db < 4; ++db) { \
                        d_[db] = *(const LAS bf16x8*)(bp + va_off + db * 32 * A_VP + (g_) * 32); } } while (0)
                    A_LDV(0, vf[0]);
                    __builtin_amdgcn_s_setprio(1);
#pragma unroll
                    for (int g = 0; g < 4; ++g) {
                        if (g + 1 < 4) A_LDV(g + 1, vf[(g + 1) & 1]);
                        __builtin_amdgcn_sched_barrier(0);
                        const bf16x8 pb = __builtin_bit_cast(bf16x8, pw[g]);
#pragma unroll
                        for (int db = 0; db < 4; ++db) oacc[db] = MFMA32(vf[g & 1][db], pb, oacc[db]);
                        __builtin_amdgcn_sched_barrier(0);
                    }
#undef A_LDV
                    __builtin_amdgcn_s_setprio(0);
                }
            }
            if (kt + 1 < nt) A_STORE(cur ^ 1);
            __syncthreads();
        }
#undef A_LOAD
#undef A_STORE
        if (has_next) attn_preload(nxt, qa, qb4, kr, vr);
        const float l_tot = xhalf_sum(l_run);
        bf16_t* mp = Mb + (size_t)(q0w + r) * DM + 4 * h;
        if (DIL) {
            const float inv = 1.0f / l_tot;
#pragma unroll
            for (int db = 0; db < 4; ++db)
#pragma unroll
                for (int g = 0; g < 4; ++g) {
                    u32x2 wv; wv.x = pk_bf16(oacc[db][4 * g] * inv, oacc[db][4 * g + 1] * inv); wv.y = pk_bf16(oacc[db][4 * g + 2] * inv, oacc[db][4 * g + 3] * inv);
                    *(u32x2*)(mp + 32 * db + 8 * g) = wv;
                }
        } else if (pass == 0) {
            const float inv = 1.0f / l_tot;
#pragma unroll
            for (int db = 0; db < 4; ++db)
#pragma unroll
                for (int g = 0; g < 4; ++g) {
                    u32x2 wv; wv.x = pk_bf16(oacc[db][4 * g] * inv, oacc[db][4 * g + 1] * inv); wv.y = pk_bf16(oacc[db][4 * g + 2] * inv, oacc[db][4 * g + 3] * inv);
                    *(u32x2*)(mp + 32 * db + 8 * g) = wv;
                }
        } else {
            const float inv2 = lam / l_tot;
            float ss = 0.f;
#pragma unroll
            for (int db = 0; db < 4; ++db)
#pragma unroll
                for (int g = 0; g < 4; ++g) {
                    const u32x2 o1 = *(const volatile u32x2*)(mp + 32 * db + 8 * g);
                    const float a0 = bf_lo(o1.x) - oacc[db][4 * g] * inv2, a1 = bf_hi(o1.x) - oacc[db][4 * g + 1] * inv2;
                    const float a2 = bf_lo(o1.y) - oacc[db][4 * g + 2] * inv2, a3 = bf_hi(o1.y) - oacc[db][4 * g + 3] * inv2;
                    oacc[db][4 * g] = a0; oacc[db][4 * g + 1] = a1; oacc[db][4 * g + 2] = a2; oacc[db][4 * g + 3] = a3;
                    ss += a0 * a0 + a1 * a1 + a2 * a2 + a3 * a3;
                }
            ss = xhalf_sum(ss);
            const float rn = __builtin_amdgcn_rsqf(ss * (1.0f / 128.0f) + 1e-5f) * 0.8f;
#pragma unroll
            for (int db = 0; db < 4; ++db)
#pragma unroll
                for (int g = 0; g < 4; ++g) {
                    const f32x4 gv = *(const f32x4*)(subg + 32 * db + 8 * g + 4 * h);
                    u32x2 wv; wv.x = pk_bf16(oacc[db][4 * g] * rn * gv[0], oacc[db][4 * g + 1] * rn * gv[1]); wv.y = pk_bf16(oacc[db][4 * g + 2] * rn * gv[2], oacc[db][4 * g + 3] * rn * gv[3]);
                    *(u32x2*)(mp + 32 * db + 8 * g) = wv;
                }
        }
    }
}
DI void diff_scores(LAS unsigned char* bp, unsigned koff, const bf16x8 (&qf)[4], bool diag, bool first, int base, float& m_run, float& l_run, f32x16 (&oacc)[4], u32x4 (&pw)[4]) {
    f32x16 s0, s1;
    const float sinit = -m_run;
#pragma unroll
    for (int i = 0; i < 16; ++i) { s0[i] = sinit; s1[i] = sinit; }
    __builtin_amdgcn_s_setprio(1);
#pragma unroll
    for (int ks = 0; ks < 4; ++ks) {
        const bf16x8 a0 = *(const LAS bf16x8*)(bp + koff + ks * 32);
        const bf16x8 a1 = *(const LAS bf16x8*)(bp + koff + 32 * A_KP + ks * 32);
        s0 = MFMA32(a0, qf[ks], s0); s1 = MFMA32(a1, qf[ks], s1);
    }
    __builtin_amdgcn_s_setprio(0);
    float mx = -1e30f;
    if (diag) {
#pragma unroll
        for (int kb = 0; kb < 2; ++kb)
#pragma unroll
            for (int i = 0; i < 16; ++i) {
                const int dlt = base - (32 * kb + (i & 3) + 8 * (i >> 2));
                const float t = dlt >= 0 ? (kb ? s1[i] : s0[i]) : -1e30f;
                if (kb) s1[i] = t; else s0[i] = t;
                mx = fmaxf(mx, t);
            }
    } else {
#pragma unroll
        for (int i = 0; i < 16; ++i) mx = fmaxf(mx, fmaxf(s0[i], s1[i]));
    }
    mx = xhalf_max(mx);
    if (first || __any(mx > 8.0f)) {
        const float delta = first ? mx : fmaxf(mx, 0.f);
        m_run += delta;
        if (!first) {
            const float alpha = __builtin_amdgcn_exp2f(-delta);
            l_run *= alpha;
#pragma unroll
            for (int db = 0; db < 4; ++db)
#pragma unroll
                for (int i = 0; i < 16; ++i) oacc[db][i] *= alpha;
        }
#pragma unroll
        for (int i = 0; i < 16; ++i) { s0[i] -= delta; s1[i] -= delta; }
    }
    float ls = 0.f, ls2 = 0.f;
#pragma unroll
    for (int i = 0; i < 16; ++i) { const float p0 = __builtin_amdgcn_exp2f(s0[i]), p1 = __builtin_amdgcn_exp2f(s1[i]); s0[i] = p0; s1[i] = p1; ls += p0; asm volatile("" : "+v"(ls)); ls2 += p1; asm volatile("" : "+v"(ls2)); }
    l_run += ls + ls2;
#pragma unroll
    for (int s = 0; s < 2; ++s) {
        pw[s].x = pk_bf16(s0[8 * s + 0], s0[8 * s + 1]); pw[s].y = pk_bf16(s0[8 * s + 2], s0[8 * s + 3]); pw[s].z = pk_bf16(s0[8 * s + 4], s0[8 * s + 5]); pw[s].w = pk_bf16(s0[8 * s + 6], s0[8 * s + 7]);
        pw[2 + s].x = pk_bf16(s1[8 * s + 0], s1[8 * s + 1]); pw[2 + s].y = pk_bf16(s1[8 * s + 2], s1[8 * s + 3]); pw[2 + s].z = pk_bf16(s1[8 * s + 4], s1[8 * s + 5]); pw[2 + s].w = pk_bf16(s1[8 * s + 6], s1[8 * s + 7]);
    }
}
DI void attn_item_diff(LAS unsigned char* lds, const bf16_t* Qb, const bf16_t* Kb, const bf16_t* VTb, bf16_t* Mb, int qb, float lam, const float* subg,
                       bf16x8 (&qa)[4], bf16x8 (&qb4)[4], u32x4 (&kr)[2], u32x4 (&vr)[2], bool has_next, const AItem& nxt) {
    const int tid = opaque_tid(), lane = tid & 63, w = __builtin_amdgcn_readfirstlane(tid >> 6), r = lane & 31, h = lane >> 5;
    const int q0w = qb * 256 + w * 32;
    const int nt = 4 * qb + 4;
    const int k_row0 = tid >> 4, k_c = tid & 15, v_row0 = tid >> 3, v_c = tid & 7;
    const bf16_t* kg = Kb + (size_t)k_row0 * 4096 + k_c * 8;
    const bf16_t* vg = VTb + (size_t)v_row0 * 32768 + v_c * 8;
    const unsigned k_l = k_row0 * A_KP + k_c * 16, v_l = A_KB + v_row0 * A_VP + (v_c >> 1) * 32 + (v_c & 1) * 8;
    const unsigned ka_off = r * A_KP + h * 16, va_off = A_KB + r * A_VP + h * 16;
    f32x16 oa[4], ob[4];
#pragma unroll
    for (int db = 0; db < 4; ++db)
#pragma unroll
        for (int i = 0; i < 16; ++i) { oa[db][i] = 0.f; ob[db][i] = 0.f; }
    float m1 = 0.f, m2 = 0.f, l1 = 0.f, l2 = 0.f;
#define D_LOAD(kt) do { _Pragma("unroll") for (int i_ = 0; i_ < 2; ++i_) { \
        kr[i_] = *(const u32x4*)(kg + (size_t)((kt) * 64 + i_ * 32) * 4096); \
        vr[i_] = *(const u32x4*)(vg + (size_t)(i_ * 64) * 32768 + (kt) * 64); } } while (0)
#define D_STORE(buf) do { LAS unsigned char* b_ = lds + (buf) * A_BUF; _Pragma("unroll") for (int i_ = 0; i_ < 2; ++i_) { \
        *(LAS u32x4*)(b_ + k_l + i_ * 32 * A_KP) = kr[i_]; \
        u32x2 lo_ = {vr[i_].x, vr[i_].y}, hi_ = {vr[i_].z, vr[i_].w}; \
        *(LAS u32x2*)(b_ + v_l + i_ * 64 * A_VP) = lo_; *(LAS u32x2*)(b_ + v_l + i_ * 64 * A_VP + 16) = hi_; } } while (0)
    D_STORE(0); __syncthreads();
    for (int kt = 0; kt < nt; ++kt) {
        const int cur = kt & 1;
        if (kt + 1 < nt) D_LOAD(kt + 1);
        if (kt * 64 <= q0w + 31) {
            LAS unsigned char* bp = lds + cur * A_BUF;
            const bool diag = kt * 64 + 63 > q0w;
            const int base = q0w + r - 4 * h - kt * 64;
            u32x4 pw[4];
#define D_PV(acc_) do { __builtin_amdgcn_s_setprio(1); _Pragma("unroll") for (int g = 0; g < 4; ++g) { \
                const bf16x8 pb_ = __builtin_bit_cast(bf16x8, pw[g]); \
                _Pragma("unroll") for (int db = 0; db < 4; ++db) { \
                    const bf16x8 va_ = *(const LAS bf16x8*)(bp + va_off + db * 32 * A_VP + g * 32); \
                    acc_[db] = MFMA32(va_, pb_, acc_[db]); } } \
                __builtin_amdgcn_s_setprio(0); } while (0)
            diff_scores(bp, ka_off, qa, diag, kt == 0, base, m1, l1, oa, pw);
            D_PV(oa);
            diff_scores(bp, ka_off + 128, qb4, diag, kt == 0, base, m2, l2, ob, pw);
            D_PV(ob);
#undef D_PV
        }
        if (kt + 1 < nt) D_STORE(cur ^ 1);
        __syncthreads();
    }
#undef D_LOAD
#undef D_STORE
    if (has_next) attn_preload(nxt, qa, qb4, kr, vr);
    const float inv1 = 1.0f / xhalf_sum(l1), inv2 = lam / xhalf_sum(l2);
    bf16_t* mp = Mb + (size_t)(q0w + r) * DM + 4 * h;
    float ss = 0.f;
#pragma unroll
    for (int db = 0; db < 4; ++db)
#pragma unroll
        for (int i = 0; i < 16; ++i) { const float a = oa[db][i] * inv1 - ob[db][i] * inv2; oa[db][i] = a; ss += a * a; }
    ss = xhalf_sum(ss);
    const float rn = __builtin_amdgcn_rsqf(ss * (1.0f / 128.0f) + 1e-5f) * 0.8f;
#pragma unroll
    for (int db = 0; db < 4; ++db)
#pragma unroll
        for (int g = 0; g < 4; ++g) {
            const f32x4 gv = *(const f32x4*)(subg + 32 * db + 8 * g + 4 * h);
            u32x2 wv; wv.x = pk_bf16(oa[db][4 * g] * rn * gv[0], oa[db][4 * g + 1] * rn * gv[1]); wv.y = pk_bf16(oa[db][4 * g + 2] * rn * gv[2], oa[db][4 * g + 3] * rn * gv[3]);
            *(u32x2*)(mp + 32 * db + 8 * g) = wv;
        }
}
DI void attn_phase(LAS unsigned char* lds, const Params& p) {
    float d1 = 0.f, d2 = 0.f;
    for (int i = 0; i < 64; ++i) { d1 += p.lq1[i] * p.lk1[i]; d2 += p.lq2[i] * p.lk2[i]; }
    const float lam = __expf(d1) - __expf(d2) + 0.2f;
    const bf16_t* QK = (const bf16_t*)(p.ws + WS_QK); const bf16_t* VT = (const bf16_t*)(p.ws + WS_VT); bf16_t* MIX = (bf16_t*)(p.ws + WS_XB);
    {
        LAS float* tb = (LAS float*)(lds + A_TBL);
        for (int idx = opaque_tid(); idx < A_TBL_N; idx += 512) {
            const int dlt = idx - 128;
            const int cnt = (dlt <= 128 ? 1 : 0) + ((((dlt & 3) == 0) && dlt <= 512) ? 1 : 0) + (((dlt & 15) == 0) ? 1 : 0);
            tb[idx] = (dlt < 0 || cnt == 0) ? -1e30f : (cnt == 3 ? 1.5849625007211562f : (cnt == 2 ? 1.0f : 0.0f));
        }
        __syncthreads();
    }
    const int nit = blockIdx.x < 1024 ? 2 * ((1024 - (int)blockIdx.x + (int)gridDim.x - 1) / (int)gridDim.x) : 0;
    auto desc = [&](int j) {
        const int idx = blockIdx.x + (j >> 1) * gridDim.x;
        const int rr = idx >> 8, v = idx & 255, x = v & 7, s = v >> 3, gq = s >> 2, mm = s & 3;
        const int combo = rr * 64 + x * 8 + gq;
        const int type = combo >> 7, b = (combo >> 3) & 15, hh = combo & 7;
        AItem it;
        it.Qb = QK + (size_t)b * SEQ * 4096 + type * 2048 + hh * 128; it.Kb = it.Qb + 1024;
        it.VTb = VT + (size_t)(type * 1024 + hh * 128) * TOK + b * SEQ;
        it.Mb = MIX + (size_t)b * SEQ * DM + type * 1024 + hh * 128;
        it.qb = (j & 1) ? mm : 7 - mm; it.type = type;
        return it;
    };
    bf16x8 qa[4], qb4[4]; u32x4 kr[2], vr[2];
    if (nit > 0) { const AItem it0 = desc(0); attn_preload(it0, qa, qb4, kr, vr); }
#pragma unroll 1
    for (int j = 0; j < nit; ++j) {
        const AItem it = desc(j);
        const bool hn = j + 1 < nit;
        const AItem nx = desc(hn ? j + 1 : j);
        if (it.type) attn_item<true>(lds, it.Qb, it.Kb, it.VTb, it.Mb, it.qb, lam, p.subg, qa, qb4, kr, vr, hn, nx);
        else attn_item_diff(lds, it.Qb, it.Kb, it.VTb, it.Mb, it.qb, lam, p.subg, qa, qb4, kr, vr, hn, nx);
    }
}

DI float wave_sum(float v) {
#pragma unroll
    for (int o = 32; o >= 1; o >>= 1) v += __shfl_xor(v, o);
    return v;
}
DI void ln_phase(const bf16_t* in, float* of, bf16_t* ob, float* stats, const float* g, const float* b) {
    const int tid = opaque_tid(); const int lane = tid & 63, gw = blockIdx.x * 8 + (tid >> 6), nw = gridDim.x * 8;
    u32x4 nx[4];
    if (gw < TOK) {
#pragma unroll
        for (int i = 0; i < 4; ++i) nx[i] = __builtin_nontemporal_load((const u32x4*)(in + (size_t)gw * DM + i * 512 + lane * 8));
    }
    for (int row = gw; row < TOK; row += nw) {
        float v[32]; float s = 0.f;
#pragma unroll
        for (int i = 0; i < 4; ++i)
#pragma unroll
            for (int j = 0; j < 4; ++j) { v[8 * i + 2 * j] = bf_lo(nx[i][j]); v[8 * i + 2 * j + 1] = bf_hi(nx[i][j]); s += v[8 * i + 2 * j] + v[8 * i + 2 * j + 1]; }
        if (row + nw < TOK) {
#pragma unroll
            for (int i = 0; i < 4; ++i) nx[i] = __builtin_nontemporal_load((const u32x4*)(in + (size_t)(row + nw) * DM + i * 512 + lane * 8));
        }
        const float mean = wave_sum(s) * (1.0f / DM);
        float q = 0.f;
#pragma unroll
        for (int e = 0; e < 32; ++e) { const float d = v[e] - mean; q += d * d; }
        const float rstd = 1.0f / sqrtf(wave_sum(q) * (1.0f / DM) + 1e-5f);
        if (stats && lane == 0) { f32x2 st = {mean, rstd}; *(f32x2*)(stats + 2 * row) = st; }
#pragma unroll
        for (int i = 0; i < 4; ++i) {
            const int c = i * 512 + lane * 8;
            const f32x4 g0 = *(const f32x4*)(g + c), g1 = *(const f32x4*)(g + c + 4), b0 = *(const f32x4*)(b + c), b1 = *(const f32x4*)(b + c + 4);
            f32x4 y0, y1;
#pragma unroll
            for (int j = 0; j < 4; ++j) { y0[j] = (v[8 * i + j] - mean) * rstd * g0[j] + b0[j]; y1[j] = (v[8 * i + 4 + j] - mean) * rstd * g1[j] + b1[j]; }
            if (of) { __builtin_nontemporal_store(y0, (f32x4*)(of + (size_t)row * DM + c)); __builtin_nontemporal_store(y1, (f32x4*)(of + (size_t)row * DM + c + 4)); }
            if (ob) { u32x4 wv; wv.x = pk_bf16(y0[0], y0[1]); wv.y = pk_bf16(y0[2], y0[3]); wv.z = pk_bf16(y1[0], y1[1]); wv.w = pk_bf16(y1[2], y1[3]); *(u32x4*)(ob + (size_t)row * DM + c) = wv; }
        }
    }
}

typedef const __attribute__((address_space(4))) Params* KParamsPtr;
DI Params load_params() {
#if defined(__HIP_DEVICE_COMPILE__)
    unsigned long long a = (unsigned long long)__builtin_amdgcn_kernarg_segment_ptr();
    asm volatile("" : "+s"(a));
    KParamsPtr kp = (KParamsPtr)a;
    Params r;
    r.x = kp->x; r.w_in = kp->w_in; r.lq1 = kp->lq1; r.lk1 = kp->lk1; r.lq2 = kp->lq2; r.lk2 = kp->lk2; r.subg = kp->subg; r.w_out = kp->w_out;
    r.ln1g = kp->ln1g; r.ln1b = kp->ln1b; r.w_ff1 = kp->w_ff1; r.w_ff2 = kp->w_ff2; r.ln2g = kp->ln2g; r.ln2b = kp->ln2b; r.out = kp->out; r.ws = kp->ws;
    return r;
#else
    return Params{};
#endif
}
#define PHASE_PARAMS() const Params p = load_params(); unsigned char* ws = p.ws; \
    bf16_t* XB = (bf16_t*)(ws + WS_XB); bf16_t* QK = (bf16_t*)(ws + WS_QK); bf16_t* VT = (bf16_t*)(ws + WS_VT); bf16_t* X1B = (bf16_t*)(ws + WS_X1B); bf16_t* HDN = (bf16_t*)(ws + WS_HDN); \
    (void)XB; (void)QK; (void)VT; (void)X1B; (void)HDN
__global__ void __launch_bounds__(512, 2) fwd_megakernel(Params p_in) {
    extern __shared__ __attribute__((aligned(16))) unsigned char lds_raw[];
    LAS unsigned char* lds = (LAS unsigned char*)lds_raw;
    cg::grid_group grid = cg::this_grid();
    __shared__ __attribute__((aligned(16))) unsigned xb_st[4];
    if (threadIdx.x < 4) xb_st[threadIdx.x] = 0u;
    __syncthreads();
    const XcdBarrier xbar = xcd_barrier_post((unsigned*)(p_in.ws + WS_BAR), (volatile LAS unsigned*)xb_st);
    const int G = gridDim.x, bid = blockIdx.x;

    { PHASE_PARAMS(); p0_phase(lds, p); __syncthreads(); }
    grid.sync();
    {
        PHASE_PARAMS();
        pg8::Gemm g{XB, (const bf16_t*)(ws + WS_WQK), TOK, 4096, DM}; pg8::StaticOrder S; S.init(TOK, 4096, G, bid);
        EpiRope E{QK, (const float*)(ws + WS_TABA), (const float*)(ws + WS_TABB)};
        pg8::gemm_phase<EpiRope, pg8::StaticOrder>(lds, g, S, E, nullptr);
    }
    {
        PHASE_PARAMS();
        pg8::Gemm g{(const bf16_t*)(ws + WS_WV), XB, 2048, TOK, DM}; pg8::StaticOrder S; S.init(2048, TOK, G, bid);
        EpiBf<0> E{VT, TOK};
        pg8::gemm_phase<EpiBf<0>, pg8::StaticOrder>(lds, g, S, E, nullptr);
    }
    xcd_barrier(xbar);
    { PHASE_PARAMS(); attn_phase(lds, p); }
    xcd_barrier(xbar);
    {
        PHASE_PARAMS();
        pg8::Gemm g{XB, (const bf16_t*)(ws + WS_WOUT), TOK, DM, DM}; pg8::StaticOrder S; S.init(TOK, DM, G, bid);
        EpiResBf E{p.x, (bf16_t*)p.out};
        pg8::gemm_phase<EpiResBf, pg8::StaticOrder>(lds, g, S, E, nullptr);
    }
    xcd_barrier(xbar);
    { PHASE_PARAMS(); ln_phase((const bf16_t*)p.out, nullptr, X1B, (float*)(ws + WS_STATS), p.ln1g, p.ln1b); }
    xcd_barrier(xbar);
    {
        PHASE_PARAMS();
        pg8::Gemm g{X1B, (const bf16_t*)(ws + WS_WFF1), TOK, DFF, DM}; pg8::StaticOrder S; S.init(TOK, DFF, G, bid);
        EpiBf<1> E{HDN, DFF};
        pg8::gemm_phase<EpiBf<1>, pg8::StaticOrder>(lds, g, S, E, nullptr);
    }
    xcd_barrier(xbar);
    {
        PHASE_PARAMS();
        pg8::Gemm g{HDN, (const bf16_t*)(ws + WS_WFF2), TOK, DM, DFF}; pg8::StaticOrder S; S.init(TOK, DM, G, bid);
        EpiResLnBf E{(const bf16_t*)p.out, (const float*)(ws + WS_STATS), p.ln1g, p.ln1b, X1B};
        pg8::gemm_phase<EpiResLnBf, pg8::StaticOrder>(lds, g, S, E, nullptr);
    }
    xcd_barrier(xbar);
    { PHASE_PARAMS(); ln_phase(X1B, p.out, nullptr, nullptr, p.ln2g, p.ln2b); }
}

extern "C" void kernel_launch(void* const* d_in, const int* in_sizes, int n_in, void* d_out, int out_size, void* d_ws, size_t ws_size, hipStream_t stream) {
    static int grid = 0;
    if (grid == 0) {
        if (n_in != 14 || in_sizes[0] != TOK * DM || out_size != TOK * DM || ws_size < WS_END) {
            fprintf(stderr, "kernel_launch: unexpected shapes (n_in %d, in0 %d, out %d, ws %zu)\n", n_in, n_in > 0 ? in_sizes[0] : -1, out_size, ws_size); grid = -1; return; }
        int dev = 0, cus = 0, per_cu = 0;
        (void)hipGetDevice(&dev); (void)hipDeviceGetAttribute(&cus, hipDeviceAttributeMultiprocessorCount, dev);
        if (hipFuncSetAttribute((const void*)fwd_megakernel, hipFuncAttributeMaxDynamicSharedMemorySize, LDS_BYTES) != hipSuccess) { fprintf(stderr, "kernel_launch: hipFuncSetAttribute failed\n"); grid = -1; return; }
        if (hipOccupancyMaxActiveBlocksPerMultiprocessor(&per_cu, (const void*)fwd_megakernel, 512, LDS_BYTES) != hipSuccess || per_cu < 1) { fprintf(stderr, "kernel_launch: occupancy query gave %d\n", per_cu); per_cu = 1; }
        (void)hipGetLastError();
        grid = cus * per_cu;
    }
    if (grid < 0) return;
    Params p{};
    p.x = (const float*)d_in[0]; p.w_in = (const float*)d_in[1]; p.lq1 = (const float*)d_in[2]; p.lk1 = (const float*)d_in[3]; p.lq2 = (const float*)d_in[4]; p.lk2 = (const float*)d_in[5];
    p.subg = (const float*)d_in[6]; p.w_out = (const float*)d_in[7]; p.ln1g = (const float*)d_in[8]; p.ln1b = (const float*)d_in[9]; p.w_ff1 = (const float*)d_in[10]; p.w_ff2 = (const float*)d_in[11];
    p.ln2g = (const float*)d_in[12]; p.ln2b = (const float*)d_in[13]; p.out = (float*)d_out; p.ws = (unsigned char*)d_ws;
    if (hipMemsetAsync((unsigned char*)d_ws + WS_BAR, 0, XCD_BAR_WORDS * sizeof(unsigned), stream) != hipSuccess) { fprintf(stderr, "kernel_launch: hipMemsetAsync of the barrier words failed\n"); return; }
    void* args[] = {&p};
    hipError_t e = hipLaunchCooperativeKernel((const void*)fwd_megakernel, dim3(grid), dim3(512), args, LDS_BYTES, stream);
    if (e != hipSuccess) fprintf(stderr, "kernel_launch: cooperative launch failed: %s (grid %d)\n", hipGetErrorString(e), grid);
}
```
